# Optimizing an MI355X kernel written in HIP

```python
import math
import jax, jax.numpy as jnp
from jax import lax
import numpy as np


D_MODEL = 4096
BATCH = 4
SEQ = 2048
DEPTH = 4

N_MIXERS = 3
N_NSA = (DEPTH + 2) // 3
N_RG = (DEPTH + 1) // 3
N_HG = DEPTH // 3
NORM_EPS = 1e-6

NSA_HEADS = 32
NSA_KV_GROUPS = 4
NSA_Q_PER_GROUP = NSA_HEADS // NSA_KV_GROUPS
NSA_HEAD_DIM = D_MODEL // NSA_HEADS
NSA_INNER = NSA_HEADS * NSA_HEAD_DIM
NSA_KV = NSA_KV_GROUPS * NSA_HEAD_DIM
NSA_IN = NSA_INNER + 6 * NSA_KV + 3 * NSA_HEADS + NSA_INNER
CMP_LEN = 32
CMP_STRIDE = 16
SEL_LEN = 64
SEL_TOPK = 16
WINDOW = 512
SEL_QCHUNK = 16
WIN_QBLOCK = 128
ALIBI_MAX_EXP = 8.0
NEG_INF = -1e30
FORCE_SCORE = 1e6

RG_WIDTH = D_MODEL
RG_BLOCKS = 16
RG_BLOCK = RG_WIDTH // RG_BLOCKS
RG_CONV = 4
RG_C = 8.0

HG_HEADS = 32
HG_KEY_DIM = 128
HG_VAL_DIM = D_MODEL // HG_HEADS
HG_KEY = HG_HEADS * HG_KEY_DIM
HG_VAL = HG_HEADS * HG_VAL_DIM
HG_IN = 2 * HG_KEY + 2 * HG_VAL
HG_CHUNK = 64

kernel_name = 'hybrid_nsa_rglru_hgrn2_sandwich'


def _rmsnorm(x, gain):
    xf = x.astype(jnp.float32)
    y = xf * lax.rsqrt(jnp.mean(xf * xf, axis=-1, keepdims=True) + NORM_EPS)
    return (y * gain.astype(jnp.float32)).astype(x.dtype)


def _split(t, sizes):
    cuts = [int(c) for c in np.cumsum(sizes)[:-1]]
    return jnp.split(t, cuts, axis=-1)


def _alibi_slopes():
    return 2.0 ** (-ALIBI_MAX_EXP * jnp.arange(1, NSA_HEADS + 1, dtype=jnp.float32) / NSA_HEADS)


def _compress(t, pe, w1, w2):
    bsz, seq, g, d = t.shape
    ratio = CMP_LEN // CMP_STRIDE
    n_chunk = seq // CMP_STRIDE
    n_cmp = n_chunk - ratio + 1
    chunks = t.reshape(bsz, n_chunk, CMP_STRIDE, g, d)
    blocks = jnp.concatenate([chunks[:, r:r + n_cmp] for r in range(ratio)], axis=2)
    blocks = blocks + pe[None, None, :, None, :].astype(t.dtype)
    flat = blocks.transpose(0, 1, 3, 2, 4).reshape(bsz, n_cmp, g, CMP_LEN * d)
    return jax.nn.gelu(flat @ w1) @ w2


def _nsa_select(q, ks, vs, p_cmp, slopes, pos, scale):
    bsz, seq, g, hg, d = q.shape
    c_ratio = CMP_LEN // CMP_STRIDE
    s_ratio = SEL_LEN // CMP_STRIDE
    n_sel = seq // SEL_LEN
    pg = p_cmp.sum(axis=2)
    padded = jnp.pad(pg, ((0, 0), (0, 0), (0, 0), (c_ratio - 1, c_ratio - 1)))
    span = s_ratio * (n_sel - 1) + 1
    p_slc = sum(padded[..., m + n:m + n + span:s_ratio] for m in range(s_ratio) for n in range(c_ratio))
    blk = jnp.arange(n_sel)[None, :]
    cur = (jnp.arange(seq) // SEL_LEN)[:, None]
    forced = (blk == 0) | (blk == cur) | (blk == cur - 1)
    future = blk > cur
    score = jnp.where(forced, FORCE_SCORE, jnp.where(future, -1.0, p_slc))
    n_top = min(SEL_TOPK, n_sel)
    _, idx = lax.top_k(score, n_top)

    k_blocks = ks.reshape(bsz, n_sel, SEL_LEN, g, d).transpose(0, 3, 1, 2, 4)
    v_blocks = vs.reshape(bsz, n_sel, SEL_LEN, g, d).transpose(0, 3, 1, 2, 4)
    n_q = seq // SEL_QCHUNK
    q_ch = q.transpose(0, 2, 1, 3, 4).reshape(bsz, g, n_q, SEL_QCHUNK, hg, d).transpose(2, 0, 1, 3, 4, 5)
    idx_ch = idx.reshape(bsz, g, n_q, SEL_QCHUNK, n_top).transpose(2, 0, 1, 3, 4)
    t_ch = pos.reshape(n_q, SEL_QCHUNK)
    gather = jax.vmap(jax.vmap(lambda blocks, ix: blocks[ix]))
    offs = jnp.arange(SEL_LEN)
    n_keys = n_top * SEL_LEN

    def sel_chunk(args):
        qq, ii, tt = args
        kk = gather(k_blocks, ii).reshape(bsz, g, SEL_QCHUNK, n_keys, d)
        vv = gather(v_blocks, ii).reshape(bsz, g, SEL_QCHUNK, n_keys, d)
        kpos = (ii[..., None] * SEL_LEN + offs).reshape(bsz, g, SEL_QCHUNK, n_keys).astype(jnp.float32)
        dist = (tt[None, None, :, None] - kpos)[:, :, :, None, :]
        s = jnp.einsum('bgqhd,bgqkd->bgqhk', qq, kk).astype(jnp.float32) * scale
        s = s - slopes[None, :, None, :, None] * dist
        s = jnp.where(dist >= 0, s, NEG_INF)
        pr = jax.nn.softmax(s, axis=-1)
        return jnp.einsum('bgqhk,bgqkd->bgqhd', pr.astype(vv.dtype), vv)

    o = lax.map(sel_chunk, (q_ch, idx_ch, t_ch))
    return o.transpose(1, 0, 3, 2, 4, 5).reshape(bsz, seq, g, hg, d)


def _nsa_window(q, kw, vw, slopes, scale):
    bsz, seq, g, hg, d = q.shape
    n_blk = seq // WIN_QBLOCK
    kw_pad = jnp.pad(kw, ((0, 0), (WINDOW, 0), (0, 0), (0, 0)))
    vw_pad = jnp.pad(vw, ((0, 0), (WINDOW, 0), (0, 0), (0, 0)))
    q_blk = q.reshape(bsz, n_blk, WIN_QBLOCK, g, hg, d).transpose(1, 0, 2, 3, 4, 5)
    span = WIN_QBLOCK + WINDOW

    def win_block(args):
        c, qq = args
        start = c * WIN_QBLOCK
        kk = lax.dynamic_slice_in_dim(kw_pad, start, span, axis=1)
        vv = lax.dynamic_slice_in_dim(vw_pad, start, span, axis=1)
        tq = (start + jnp.arange(WIN_QBLOCK)).astype(jnp.float32)
        tk = (start - WINDOW + jnp.arange(span)).astype(jnp.float32)
        dist = tq[:, None] - tk[None, :]
        valid = (dist >= 0) & (dist < WINDOW) & (tk[None, :] >= 0)
        s = jnp.einsum('bqghd,bkgd->bghqk', qq, kk).astype(jnp.float32) * scale
        s = jnp.where(valid, s - slopes[None, :, :, None, None] * dist, NEG_INF)
        pr = jax.nn.softmax(s, axis=-1)
        return jnp.einsum('bghqk,bkgd->bqghd', pr.astype(vv.dtype), vv)

    o = lax.map(win_block, (jnp.arange(n_blk), q_blk))
    return o.transpose(1, 0, 2, 3, 4, 5).reshape(bsz, seq, g, hg, d)


def _nsa_mixer(h, w_in, cmp_pe, cmp_w1, cmp_w2, w_out):
    bsz, seq, _ = h.shape
    f32 = jnp.float32
    scale = NSA_HEAD_DIM ** -0.5
    q, kc, vc, ks, vs, kw, vw, gl, z = _split(h @ w_in, [NSA_INNER] + [NSA_KV] * 6 + [3 * NSA_HEADS, NSA_INNER])
    q = q.reshape(bsz, seq, NSA_KV_GROUPS, NSA_Q_PER_GROUP, NSA_HEAD_DIM)
    kc, vc, ks, vs, kw, vw = [t.reshape(bsz, seq, NSA_KV_GROUPS, NSA_HEAD_DIM) for t in (kc, vc, ks, vs, kw, vw)]
    slopes = _alibi_slopes().reshape(NSA_KV_GROUPS, NSA_Q_PER_GROUP)
    pos = jnp.arange(seq, dtype=f32)

    k_cmp = _compress(kc, cmp_pe[0], cmp_w1[0], cmp_w2[0])
    v_cmp = _compress(vc, cmp_pe[1], cmp_w1[1], cmp_w2[1])
    n_cmp = k_cmp.shape[1]
    cmp_end = jnp.arange(n_cmp, dtype=f32) * CMP_STRIDE + (CMP_LEN - 1)
    dist = pos[:, None] - cmp_end[None, :]
    valid = dist >= 0
    s = jnp.einsum('bsgjd,bngd->bgjsn', q, k_cmp).astype(f32) * scale - slopes[None, :, :, None, None] * dist
    s = jnp.where(valid, s, NEG_INF)
    p_cmp = jax.nn.softmax(s, axis=-1) * jnp.any(valid, axis=-1)[:, None].astype(f32)
    o_cmp = jnp.einsum('bgjsn,bngd->bsgjd', p_cmp.astype(v_cmp.dtype), v_cmp)

    o_slc = _nsa_select(q, ks, vs, p_cmp, slopes, pos, scale)
    o_win = _nsa_window(q, kw, vw, slopes, scale)

    g = jax.nn.sigmoid(gl.astype(f32)).reshape(bsz, seq, 3, NSA_KV_GROUPS, NSA_Q_PER_GROUP, 1)
    o = g[:, :, 0] * o_cmp + g[:, :, 1] * o_slc + g[:, :, 2] * o_win
    y = o.reshape(bsz, seq, NSA_INNER).astype(h.dtype) * jax.nn.silu(z)
    return y @ w_out


def _lin_rec_combine(left, right):
    a_l, b_l = left
    a_r, b_r = right
    return (a_l * a_r, a_r * b_l + b_r)


def _rglru_mixer(h, w_in, conv_w, conv_b, gate_w, gate_b, lam, w_out):
    bsz, seq, _ = h.shape
    f32 = jnp.float32
    xb, z = _split(h @ w_in, [RG_WIDTH, RG_WIDTH])
    xb = lax.conv_general_dilated(xb, conv_w[:, None, :].astype(xb.dtype), window_strides=(1,), padding=[(RG_CONV - 1, 0)], dimension_numbers=('NWC', 'WIO', 'NWC'), feature_group_count=RG_WIDTH) + conv_b.astype(xb.dtype)
    xg = xb.reshape(bsz, seq, RG_BLOCKS, RG_BLOCK)
    gates = jax.nn.sigmoid((jnp.einsum('bsnc,knce->kbsne', xg, gate_w) + gate_b[:, None, None]).astype(f32)).reshape(2, bsz, seq, RG_WIDTH)
    i_gate, r_gate = gates[0], gates[1]
    log_a = -RG_C * r_gate * jax.nn.softplus(-lam.astype(f32))
    a = jnp.exp(log_a)
    mult = jnp.sqrt(-jnp.expm1(2.0 * log_a))
    mult = jnp.where((jnp.arange(seq) == 0)[None, :, None], 1.0, mult)
    u = mult * i_gate * xb.astype(f32)
    _, hs = lax.associative_scan(_lin_rec_combine, (a, u), axis=1)
    y = hs.astype(h.dtype) * jax.nn.silu(z)
    return y @ w_out


def _hgrn2_chunk_scan(q, k, v, log_f):
    bsz, nh, seq, dk = q.shape
    dv = v.shape[-1]
    n_c = seq // HG_CHUNK

    def to_chunks(t):
        return t.reshape(bsz, nh, n_c, HG_CHUNK, t.shape[-1]).transpose(2, 0, 1, 3, 4)

    causal = jnp.tril(jnp.ones((HG_CHUNK, HG_CHUNK), dtype=bool))[:, :, None]

    def step(state, inp):
        qc, kc, vc, gc = inp
        b = jnp.cumsum(gc, axis=2)
        o_inter = jnp.einsum('bhtd,bhdv->bhtv', qc * jnp.exp(b), state)
        rel = jnp.where(causal, b[:, :, :, None, :] - b[:, :, None, :, :], -jnp.inf)
        att = jnp.einsum('bhtd,bhsd,bhtsd->bhts', qc, kc, jnp.exp(rel))
        o = o_inter + jnp.einsum('bhts,bhsv->bhtv', att, vc)
        b_last = b[:, :, -1:, :]
        new_state = jnp.exp(b_last[:, :, 0, :])[..., None] * state + jnp.einsum('bhsd,bhsv->bhdv', kc * jnp.exp(b_last - b), vc)
        return new_state, o

    init = jnp.zeros((bsz, nh, dk, dv), jnp.float32)
    _, o = lax.scan(step, init, (to_chunks(q), to_chunks(k), to_chunks(v), to_chunks(log_f)))
    return o.transpose(1, 0, 3, 2, 4).reshape(bsz, seq, nh, dv)


def _hgrn2_mixer(h, w_in, lb, norm_gain, w_out):
    bsz, seq, _ = h.shape
    f32 = jnp.float32
    q, f, v, g = _split(h @ w_in, [HG_KEY, HG_KEY, HG_VAL, HG_VAL])
    q = jax.nn.silu(q.astype(f32))
    f = lb + (1.0 - lb) * jax.nn.sigmoid(f.astype(f32))
    log_f = jnp.log(f)
    k = 1.0 - f
    heads_k = lambda t: t.reshape(bsz, seq, HG_HEADS, HG_KEY_DIM).transpose(0, 2, 1, 3)
    vh = v.astype(f32).reshape(bsz, seq, HG_HEADS, HG_VAL_DIM).transpose(0, 2, 1, 3)
    o = _hgrn2_chunk_scan(heads_k(q), heads_k(k), vh, heads_k(log_f))
    o = _rmsnorm(o, norm_gain) * jax.nn.silu(g.astype(f32).reshape(bsz, seq, HG_HEADS, HG_VAL_DIM))
    return o.reshape(bsz, seq, HG_VAL).astype(h.dtype) @ w_out


def setup_inputs(seed: int = 0) -> dict:
    key = jax.random.key(seed)
    ks = jax.random.split(key, 20)
    f32 = jnp.float32

    def nrm(k, shape, scale):
        return jax.random.normal(k, shape, f32) * scale

    x = nrm(ks[0], (BATCH, SEQ, D_MODEL), 1.0)
    pre_norm_gain = 1.0 + nrm(ks[1], (DEPTH, D_MODEL), 0.02)
    post_norm_gain = 1.0 + nrm(ks[2], (DEPTH, D_MODEL), 0.02)
    nsa_w_in = nrm(ks[3], (N_NSA, D_MODEL, NSA_IN), D_MODEL ** -0.5)
    nsa_cmp_pe = nrm(ks[4], (N_NSA, 2, CMP_LEN, NSA_HEAD_DIM), 0.1)
    nsa_cmp_w1 = nrm(ks[5], (N_NSA, 2, CMP_LEN * NSA_HEAD_DIM, NSA_HEAD_DIM), (CMP_LEN * NSA_HEAD_DIM) ** -0.5)
    nsa_cmp_w2 = nrm(ks[6], (N_NSA, 2, NSA_HEAD_DIM, NSA_HEAD_DIM), NSA_HEAD_DIM ** -0.5)
    nsa_w_out = nrm(ks[7], (N_NSA, NSA_INNER, D_MODEL), NSA_INNER ** -0.5)
    rg_w_in = nrm(ks[8], (N_RG, D_MODEL, 2 * RG_WIDTH), D_MODEL ** -0.5)
    rg_conv_w = nrm(ks[9], (N_RG, RG_CONV, RG_WIDTH), RG_CONV ** -0.5)
    rg_conv_b = nrm(ks[10], (N_RG, RG_WIDTH), 0.01)
    rg_gate_w = nrm(ks[11], (N_RG, 2, RG_BLOCKS, RG_BLOCK, RG_BLOCK), RG_BLOCK ** -0.5)
    rg_gate_b = nrm(ks[12], (N_RG, 2, RG_BLOCKS, RG_BLOCK), 0.01)
    u = jax.random.uniform(ks[13], (N_RG, RG_WIDTH), f32, 0.9, 0.999)
    log_a = jnp.log(u) / RG_C
    rg_lambda = log_a - jnp.log(-jnp.expm1(log_a))
    rg_w_out = nrm(ks[14], (N_RG, RG_WIDTH, D_MODEL), RG_WIDTH ** -0.5)
    hg_w_in = nrm(ks[15], (N_HG, D_MODEL, HG_IN), D_MODEL ** -0.5)
    hg_lb_logits = nrm(ks[16], (DEPTH, HG_KEY), 0.1)
    hg_norm_gain = 1.0 + nrm(ks[17], (N_HG, HG_VAL_DIM), 0.02)
    hg_w_out = nrm(ks[18], (N_HG, HG_VAL, D_MODEL), HG_VAL ** -0.5)
    return {'x': x, 'pre_norm_gain': pre_norm_gain, 'post_norm_gain': post_norm_gain,
            'nsa_w_in': nsa_w_in, 'nsa_cmp_pe': nsa_cmp_pe, 'nsa_cmp_w1': nsa_cmp_w1, 'nsa_cmp_w2': nsa_cmp_w2, 'nsa_w_out': nsa_w_out,
            'rg_w_in': rg_w_in, 'rg_conv_w': rg_conv_w, 'rg_conv_b': rg_conv_b, 'rg_gate_w': rg_gate_w, 'rg_gate_b': rg_gate_b,
            'rg_lambda': rg_lambda, 'rg_w_out': rg_w_out,
            'hg_w_in': hg_w_in, 'hg_lb_logits': hg_lb_logits, 'hg_norm_gain': hg_norm_gain, 'hg_w_out': hg_w_out}


def reference(x, pre_norm_gain, post_norm_gain, nsa_w_in, nsa_cmp_pe, nsa_cmp_w1, nsa_cmp_w2, nsa_w_out,
              rg_w_in, rg_conv_w, rg_conv_b, rg_gate_w, rg_gate_b, rg_lambda, rg_w_out,
              hg_w_in, hg_lb_logits, hg_norm_gain, hg_w_out):
    lb_all = jax.nn.softmax(hg_lb_logits.astype(jnp.float32), axis=0)
    lb_all = jnp.cumsum(lb_all, axis=0) - lb_all[0]
    for i in range(DEPTH):
        h = _rmsnorm(x, pre_norm_gain[i])
        kind, j = i % N_MIXERS, i // N_MIXERS
        if kind == 0:
            y = _nsa_mixer(h, nsa_w_in[j], nsa_cmp_pe[j], nsa_cmp_w1[j], nsa_cmp_w2[j], nsa_w_out[j])
        elif kind == 1:
            y = _rglru_mixer(h, rg_w_in[j], rg_conv_w[j], rg_conv_b[j], rg_gate_w[j], rg_gate_b[j], rg_lambda[j], rg_w_out[j])
        else:
            y = _hgrn2_mixer(h, hg_w_in[j], lb_all[i], hg_norm_gain[j], hg_w_out[j])
        x = x + _rmsnorm(y, post_norm_gain[i])
    return x
```

```cpp
#include <hip/hip_runtime.h>
#include <cstdio>
#include <cstdint>
namespace pg8 {
#define PG8_LAS __attribute__((address_space(3)))
typedef unsigned short bf16_t;
typedef short bf16x8 __attribute__((ext_vector_type(8)));
typedef float f32x4 __attribute__((ext_vector_type(4)));
typedef unsigned u32x4 __attribute__((ext_vector_type(4)));
constexpr int BM = 256, BK = 64, HALF = 128, HTB = HALF * BK * 2  , STAGE_BYTES = 8 * HTB, NXCD = 8, WGM = 4;

__host__ __device__ __forceinline__ int lds_byte(int r, int c) { const int st = (r >> 4) * 2 + (c >> 5), rr = r & 15, cc = c & 31, ob = rr * 64 + cc * 2; return st * 1024 + (ob ^ (((ob >> 9) & 1) << 5)); }
__host__ __device__ __forceinline__ void stage_rc(int b, int& R, int& C) { const int st = b / 1024, sb = b % 1024, swz = sb ^ (((sb >> 9) & 1) << 5); R = (st >> 1) * 16 + swz / 64; C = (st & 1) * 32 + (swz % 64) / 2; }
__host__ __device__ __forceinline__ int perm32(int rho) { const int n = rho >> 4, i = rho & 15; return 8 * (i >> 2) + 4 * n + (i & 3); }

struct Unit { int pm, pn; };
struct Gemm { const bf16_t* A; const bf16_t* Bt; int M, N, K; int lda; int ablk; };

struct StaticOrder {
    int nM, nN, nwg, G, c;
    __host__ __device__ void init(int M, int N, int G_, int c_) { nM = M / BM; nN = N / BM; nwg = nM * nN; G = G_; c = c_; }
    __host__ __device__ bool next(int i, Unit& u) const {
        const long L = (long)i * G + c; if (L >= nwg) return false;
        int wgid = (int)L; { const int q = nwg / NXCD, r = nwg % NXCD, xcd = wgid % NXCD, off = wgid / NXCD; wgid = (xcd < r ? xcd * (q + 1) : r * (q + 1) + (xcd - r) * q) + off; }
        const int nig = WGM * nN, gid = wgid / nig, fm = gid * WGM, gsz = (nM - fm) < WGM ? (nM - fm) : WGM;
        u.pm = fm + ((wgid % nig) % gsz); u.pn = (wgid % nig) / gsz; return true;
    }
    __device__ __forceinline__ void a_ready(const Unit&) const {}
    __device__ __forceinline__ void done(const Unit&) const {}
};

__device__ __forceinline__ unsigned cvt_pk_bf16(float lo, float hi) { unsigned r; asm volatile("v_cvt_pk_bf16_f32 %0, %1, %2" : "=v"(r) : "v"(lo), "v"(hi)); return r; }
typedef float f32x2 __attribute__((ext_vector_type(2)));
__device__ __forceinline__ f32x2 gelu_pk(f32x2 v) {
    const f32x2 av = __builtin_elementwise_abs(v), d = av * 0.2316418882f + 1.0f;
    f32x2 t; t.x = __builtin_amdgcn_rcpf(d.x); t.y = __builtin_amdgcn_rcpf(d.y);
    f32x2 q = t * 0.5307027145f + (-0.7265760135f); q = q * t + 0.7107068705f; q = q * t + (-0.142248368f); q = q * t + 0.127414796f; q = q * t;
    const f32x2 s = (v * v) * (-0.72134752044f);
    f32x2 e; e.x = __builtin_amdgcn_exp2f(s.x); e.y = __builtin_amdgcn_exp2f(s.y);
    const f32x2 m = v * (q * e), r = v - m;
    f32x2 o; o.x = v.x < 0.f ? m.x : r.x; o.y = v.y < 0.f ? m.y : r.y; return o;
}

template <int ACT  > struct EpiBf16 {
    static constexpr bool PERM = true, AFTER_DRAIN = false; static_assert(ACT == 0 || ACT == 1, "EpiBf16: ACT is 0 (none) or 1 (gelu_pk)");
    bf16_t* O; int ldc; const float* bias; int split_cols; size_t split_stride; float scale0;
    __device__ __forceinline__ void operator()(const f32x4 (&acc)[2][2][4][2], const Unit& u, int wr, int wc, int fr, int fq) const {
        const int row0 = u.pm * BM + wr * 64 + fr; int colt = u.pn * BM; bf16_t* base = O;
        float sc = 1.f; if (split_cols) { const int t = colt / split_cols; base += (size_t)t * split_stride; colt -= t * split_cols; if (t == 0) sc = scale0; }
        const int col0 = colt + wc * 32 + 8 * fq, bcol0 = u.pn * BM + wc * 32 + 8 * fq;
        f32x4 bv[2][2];
#pragma unroll
        for (int bj = 0; bj < 2; ++bj)
#pragma unroll
            for (int n = 0; n < 2; ++n) bv[bj][n] = bias ? *(const f32x4*)(bias + bcol0 + bj * HALF + 4 * n) : (f32x4){0.f, 0.f, 0.f, 0.f};
#pragma unroll
        for (int ai = 0; ai < 2; ++ai)
#pragma unroll
            for (int m = 0; m < 4; ++m) { bf16_t* rowp = base + (size_t)(row0 + ai * HALF + m * 16) * ldc + col0;
#pragma unroll
                for (int bj = 0; bj < 2; ++bj) { f32x4 v0 = acc[ai][bj][m][0] + bv[bj][0], v1 = acc[ai][bj][m][1] + bv[bj][1];
                    if (ACT == 1) { f32x2 a = gelu_pk((f32x2){v0[0], v0[1]}), b = gelu_pk((f32x2){v0[2], v0[3]}), c = gelu_pk((f32x2){v1[0], v1[1]}), d = gelu_pk((f32x2){v1[2], v1[3]});
                        v0 = (f32x4){a.x, a.y, b.x, b.y}; v1 = (f32x4){c.x, c.y, d.x, d.y}; }
                    v0 = v0 * sc; v1 = v1 * sc; u32x4 w; w.x = cvt_pk_bf16(v0[0], v0[1]); w.y = cvt_pk_bf16(v0[2], v0[3]); w.z = cvt_pk_bf16(v1[0], v1[1]); w.w = cvt_pk_bf16(v1[2], v1[3]);
                    *(u32x4*)(rowp + bj * HALF) = w; } }
    }
};

struct EpiBf16RS {
    static constexpr bool PERM = true, AFTER_DRAIN = false;
    bf16_t* O; int ldc; const float* rs;
    __device__ __forceinline__ void operator()(const f32x4 (&acc)[2][2][4][2], const Unit& u, int wr, int wc, int fr, int fq) const {
        const int row0 = u.pm * BM + wr * 64 + fr, col0 = u.pn * BM + wc * 32 + 8 * fq;
        float scv[2][4];
#pragma unroll
        for (int ai = 0; ai < 2; ++ai)
#pragma unroll
            for (int m = 0; m < 4; ++m) scv[ai][m] = rs[row0 + ai * HALF + m * 16];
#pragma unroll
        for (int ai = 0; ai < 2; ++ai)
#pragma unroll
            for (int m = 0; m < 4; ++m) { const int row = row0 + ai * HALF + m * 16; const float sc = scv[ai][m]; bf16_t* rowp = O + (size_t)row * ldc + col0;
#pragma unroll
                for (int bj = 0; bj < 2; ++bj) { const f32x4 v0 = acc[ai][bj][m][0] * sc, v1 = acc[ai][bj][m][1] * sc;
                    u32x4 w; w.x = cvt_pk_bf16(v0[0], v0[1]); w.y = cvt_pk_bf16(v0[2], v0[3]); w.z = cvt_pk_bf16(v1[0], v1[1]); w.w = cvt_pk_bf16(v1[2], v1[3]);
                    *(u32x4*)(rowp + bj * HALF) = w; } }
    }
};

template <class Epi, class Sched, bool ALIGN_EPI = false, bool SP2 = false>
__device__ __forceinline__ void gemm_phase(PG8_LAS unsigned char* lds, const Gemm g, const Sched& S, const Epi& E) {
    const int tid = threadIdx.x, wid = __builtin_amdgcn_readfirstlane(tid >> 6), lane = tid & 63, wr = wid >> 2, wc = wid & 3, fr = lane & 15, fq = lane >> 4;
    const int K = g.K, nt = K / BK;
    unsigned voffA[2], voffB[2];
#pragma unroll
    for (int i = 0; i < 2; ++i) { int R, C; stage_rc(tid * 16 + i * 8192, R, C); const int Rb = Epi::PERM ? ((R & ~31) + perm32(R & 31)) : R;
        voffA[i] = (unsigned)(R * g.lda + C) * 2u; voffB[i] = (unsigned)(Rb * K + C) * 2u; }
    const size_t kstep = (size_t)(BK * 2);
    const size_t hstepB = (size_t)HALF * K * 2, hstepA = (size_t)HALF * g.lda * 2;
    const size_t tstepB = 2 * hstepB, tstepA = 2 * hstepA;
#define PG8_ACOL(pn_) (g.ablk ? (size_t)((pn_) >> 1) * 512u : (size_t)0)
    const unsigned ldsw = (unsigned)wid * 1024u;
    const int aoff = lds_byte(wr * 64 + fr, fq * 8), boff = lds_byte(wc * 32 + fr, fq * 8);
#define PG8_SA(b, h) (((b) * 2 + (h)) * HTB)
#define PG8_SB(b, h) ((4 + (b) * 2 + (h)) * HTB)
#define PG8_STAGE(bufoff, gbase, voff) do { _Pragma("unroll") for (int _i = 0; _i < 2; ++_i) \
        __builtin_amdgcn_global_load_lds((const unsigned*)((const char*)(gbase) + (voff)[_i]), (PG8_LAS unsigned*)(lds + (bufoff) + ldsw + _i * 8192), 16, 0, 0); } while (0)
#define PG8_LDA(dst, b, h) do { _Pragma("unroll") for (int m = 0; m < 4; ++m) _Pragma("unroll") for (int k = 0; k < 2; ++k) dst[m][k] = *(const PG8_LAS bf16x8*)(lds + PG8_SA(b, h) + aoff + m * 2048 + k * 1024); } while (0)
#define PG8_LDB(dst, b, h) do { _Pragma("unroll") for (int n = 0; n < 2; ++n) _Pragma("unroll") for (int k = 0; k < 2; ++k) dst[n][k] = *(const PG8_LAS bf16x8*)(lds + PG8_SB(b, h) + boff + n * 2048 + k * 1024); } while (0)
#define PG8_MMA(ai, bj, At, Bt) do { __builtin_amdgcn_s_setprio(1); _Pragma("unroll") for (int m = 0; m < 4; ++m) _Pragma("unroll") for (int n = 0; n < 2; ++n) _Pragma("unroll") for (int k = 0; k < 2; ++k) \
        acc[ai][bj][m][n] = __builtin_amdgcn_mfma_f32_16x16x32_bf16(Bt[n][k], At[m][k], acc[ai][bj][m][n], 0, 0, 0); __builtin_amdgcn_s_setprio(0); } while (0)
#define PG8_WAIT_V(n) asm volatile("s_waitcnt vmcnt(" #n ")" ::: "memory")
#define PG8_WAIT_L(n) asm volatile("s_waitcnt lgkmcnt(" #n ")" ::: "memory")
#define PG8_BAR __builtin_amdgcn_s_barrier()
#define PG8_SCHED __builtin_amdgcn_sched_barrier(0)
    Unit cur, nxt; int ui = 0;
    if (!S.next(0, cur)) return;
    f32x4 acc[2][2][4][2];
#pragma unroll
    for (int a = 0; a < 2; ++a)
#pragma unroll
        for (int b = 0; b < 2; ++b)
#pragma unroll
            for (int m = 0; m < 4; ++m)
#pragma unroll
                for (int n = 0; n < 2; ++n) acc[a][b][m][n] = (f32x4){0.f, 0.f, 0.f, 0.f};
    bf16x8 At[4][2], B0[2][2], B1[2][2];
    const char* cA = (const char*)g.A + (size_t)cur.pm * tstepA + PG8_ACOL(cur.pn); const char* cB = (const char*)g.Bt + (size_t)cur.pn * tstepB;
    S.a_ready(cur);
    if constexpr (SP2) {
        PG8_STAGE(PG8_SB(0, 0), cB, voffB); PG8_STAGE(PG8_SB(0, 1), cB + hstepB, voffB); PG8_STAGE(PG8_SA(0, 0), cA, voffA); PG8_STAGE(PG8_SA(0, 1), cA + hstepA, voffA);
        if (wr == 1) PG8_BAR;
        PG8_WAIT_V(2); PG8_BAR;
        PG8_STAGE(PG8_SB(1, 0), cB + kstep, voffB); PG8_STAGE(PG8_SA(1, 0), cA + kstep, voffA); PG8_STAGE(PG8_SB(1, 1), cB + hstepB + kstep, voffB);
        PG8_WAIT_V(6); PG8_BAR;
    } else {
        PG8_STAGE(PG8_SB(0, 0), cB, voffB); PG8_STAGE(PG8_SA(0, 0), cA, voffA); PG8_STAGE(PG8_SB(0, 1), cB + hstepB, voffB); PG8_STAGE(PG8_SA(0, 1), cA + hstepA, voffA);
        if (wr == 1) PG8_BAR;
        PG8_WAIT_V(4); PG8_BAR;
        PG8_STAGE(PG8_SB(1, 0), cB + kstep, voffB); PG8_STAGE(PG8_SA(1, 0), cA + kstep, voffA); PG8_STAGE(PG8_SB(1, 1), cB + hstepB + kstep, voffB);
        PG8_WAIT_V(6); PG8_BAR;
    }
    for (;;) {
        const bool has_next = S.next(ui + 1, nxt);
        const char* nA = has_next ? (const char*)g.A + (size_t)nxt.pm * tstepA + PG8_ACOL(nxt.pn) : cA; const char* nB = has_next ? (const char*)g.Bt + (size_t)nxt.pn * tstepB : cB;
        for (int t = 0; t < nt; t += 2) {
            const bool last = (t == nt - 2);
            const char* a1 = cA + (size_t)(t + 1) * kstep;
            const char* a2 = last ? nA : cA + (size_t)(t + 2) * kstep; const char* b2 = last ? nB : cB + (size_t)(t + 2) * kstep;
            const char* a3 = a2 + kstep; const char* b3 = b2 + kstep;
            if (last && has_next) S.a_ready(nxt);
            if constexpr (SP2) {
            PG8_LDB(B0, 0, 0); PG8_LDB(B1, 0, 1); PG8_SCHED; PG8_LDA(At, 0, 0); PG8_STAGE(PG8_SA(1, 1), a1 + hstepA, voffA);
            PG8_WAIT_V(8); PG8_WAIT_L(0); PG8_BAR; PG8_MMA(0, 0, At, B0); PG8_MMA(0, 1, At, B1); PG8_BAR; PG8_SCHED;
            PG8_LDA(At, 0, 1); PG8_STAGE(PG8_SB(0, 0), b2, voffB); PG8_STAGE(PG8_SB(0, 1), b2 + hstepB, voffB); PG8_STAGE(PG8_SA(0, 0), a2, voffA);
            PG8_WAIT_V(8); PG8_WAIT_L(0); PG8_BAR; PG8_MMA(1, 0, At, B0); PG8_MMA(1, 1, At, B1); PG8_BAR; PG8_SCHED;
            PG8_LDB(B0, 1, 0); PG8_LDB(B1, 1, 1); PG8_SCHED; PG8_LDA(At, 1, 0); PG8_STAGE(PG8_SA(0, 1), a2 + hstepA, voffA);
            PG8_WAIT_V(8); PG8_WAIT_L(0); PG8_BAR; PG8_MMA(0, 0, At, B0); PG8_MMA(0, 1, At, B1); PG8_BAR; PG8_SCHED;
            PG8_LDA(At, 1, 1); PG8_STAGE(PG8_SB(1, 0), b3, voffB); PG8_STAGE(PG8_SB(1, 1), b3 + hstepB, voffB); PG8_STAGE(PG8_SA(1, 0), a3, voffA);
            PG8_WAIT_V(8); PG8_WAIT_L(0); PG8_BAR; PG8_MMA(1, 0, At, B0); PG8_MMA(1, 1, At, B1); PG8_BAR; PG8_SCHED;
            } else {
            PG8_LDB(B0, 0, 0); PG8_SCHED; PG8_LDA(At, 0, 0); PG8_STAGE(PG8_SA(1, 1), a1 + hstepA, voffA);
            PG8_WAIT_L(8); PG8_BAR; PG8_WAIT_L(0); PG8_MMA(0, 0, At, B0); PG8_BAR; PG8_SCHED;
            PG8_LDB(B1, 0, 1); PG8_STAGE(PG8_SB(0, 0), b2, voffB);
            PG8_BAR; PG8_WAIT_L(0); PG8_MMA(0, 1, At, B1); PG8_BAR;
            PG8_LDA(At, 0, 1); PG8_STAGE(PG8_SA(0, 0), a2, voffA);
            PG8_BAR; PG8_WAIT_L(0); PG8_MMA(1, 0, At, B0); PG8_BAR; PG8_SCHED;
            PG8_STAGE(PG8_SB(0, 1), b2 + hstepB, voffB);
            PG8_WAIT_V(6); PG8_BAR; PG8_MMA(1, 1, At, B1); PG8_BAR;
            PG8_LDB(B0, 1, 0); PG8_SCHED; PG8_LDA(At, 1, 0); PG8_STAGE(PG8_SA(0, 1), a2 + hstepA, voffA);
            PG8_WAIT_L(8); PG8_BAR; PG8_WAIT_L(0); PG8_MMA(0, 0, At, B0); PG8_BAR; PG8_SCHED;
            PG8_LDB(B1, 1, 1); PG8_STAGE(PG8_SB(1, 0), b3, voffB);
            PG8_BAR; PG8_WAIT_L(0); PG8_MMA(0, 1, At, B1); PG8_BAR;
            PG8_LDA(At, 1, 1); PG8_STAGE(PG8_SA(1, 0), a3, voffA);
            PG8_BAR; PG8_WAIT_L(0); PG8_MMA(1, 0, At, B0); PG8_BAR; PG8_SCHED;
            PG8_STAGE(PG8_SB(1, 1), b3 + hstepB, voffB);
            PG8_WAIT_V(6); PG8_BAR; PG8_MMA(1, 1, At, B1); PG8_BAR;
            }
        }
        if constexpr (ALIGN_EPI) { if (wr == 0) PG8_BAR; }
        if constexpr (!Epi::AFTER_DRAIN) { E(acc, cur, wr, wc, fr, fq); S.done(cur); }
        if (!has_next) break;
#pragma unroll
        for (int a = 0; a < 2; ++a)
#pragma unroll
            for (int b = 0; b < 2; ++b)
#pragma unroll
                for (int m = 0; m < 4; ++m)
#pragma unroll
                    for (int n = 0; n < 2; ++n) acc[a][b][m][n] = (f32x4){0.f, 0.f, 0.f, 0.f};
        cur = nxt; cA = nA; cB = nB; ++ui;
        if constexpr (ALIGN_EPI) { if (wr == 1) PG8_BAR; }
    }
    PG8_WAIT_V(0);
    if constexpr (!ALIGN_EPI) { if (wr == 0) PG8_BAR; }
    PG8_BAR;
    if constexpr (Epi::AFTER_DRAIN) { E.fused(acc, cur, wr, wc, fr, fq, lds, wid, lane); S.done(cur); }
#undef PG8_ACOL
#undef PG8_SA
#undef PG8_SB
#undef PG8_STAGE
#undef PG8_LDA
#undef PG8_LDB
#undef PG8_MMA
#undef PG8_WAIT_V
#undef PG8_WAIT_L
#undef PG8_BAR
#undef PG8_SCHED
}
}

constexpr int BATCH = 4, SEQ = 2048, DM = 4096, MTOK = BATCH * SEQ;
constexpr int NSA_NP = 11520;
constexpr int NSA_Q = 0, NSA_KC = 4096, NSA_VC = 4608, NSA_KS = 5120, NSA_VS = 5632, NSA_KW = 6144, NSA_VW = 6656, NSA_Z = 7168, NSA_GL = 11264;
constexpr int RG_NP = 8192, HG_NP = 16384;
constexpr float NORM_EPS = 1e-6f;
constexpr int NWAVES = 8, NTHREADS = 512;

constexpr size_t MiB = 1u << 20;
constexpr size_t WS_CTL = 0, CTL_ZERO_BYTES = 32768;
constexpr size_t WS_W_NSA_IN = 2 * MiB;
constexpr size_t WS_W_NSA_OUT = 182 * MiB;
constexpr size_t WS_W_RG_IN = 246 * MiB;
constexpr size_t WS_W_RG_OUT = 310 * MiB;
constexpr size_t WS_W_HG_IN = 342 * MiB;
constexpr size_t WS_W_HG_OUT = 470 * MiB;
constexpr size_t WS_MISC = 502 * MiB;
constexpr size_t WS_H = 512 * MiB;
constexpr size_t WS_PROJ = 576 * MiB;
constexpr size_t WS_Y = 832 * MiB;
constexpr size_t WS_YO = 896 * MiB;
constexpr size_t WS_SCR = 960 * MiB;
constexpr size_t WS_END = 1216 * MiB;
constexpr size_t MISC_LB = 9 * MiB;
constexpr size_t MISC_SP = 9 * MiB + 65536;
constexpr size_t MISC_RS = 9 * MiB + 131072;
constexpr size_t MISC_GATE = 0;
constexpr int CW_BAR = 4096;

constexpr int RING_OFF = 0, RING_BYTES = 131072;
constexpr int LDS_BYTES = 163840;
constexpr int MISC_OFF = LDS_BYTES - 256;

#define LAS __attribute__((address_space(3)))
typedef unsigned short bf16;
typedef unsigned v4u __attribute__((ext_vector_type(4)));
typedef unsigned v2u __attribute__((ext_vector_type(2)));
typedef float v4f __attribute__((ext_vector_type(4)));
typedef float v2f __attribute__((ext_vector_type(2)));

__device__ __forceinline__ float bf2f(unsigned b) { return __uint_as_float(b << 16); }
__device__ __forceinline__ float bflo(unsigned w) { return __uint_as_float(w << 16); }
__device__ __forceinline__ float bfhi(unsigned w) { return __uint_as_float(w & 0xffff0000u); }
__device__ __forceinline__ unsigned f2bf(float f) { unsigned u = __float_as_uint(f); return (u + 0x7fffu + ((u >> 16) & 1u)) >> 16; }
__device__ __forceinline__ unsigned pk2(float lo, float hi) { unsigned r; asm volatile("v_cvt_pk_bf16_f32 %0, %1, %2" : "=v"(r) : "v"(lo), "v"(hi)); return r; }
__device__ __forceinline__ float wave_sum(float v) {
#pragma unroll
    for (int o = 1; o < 64; o <<= 1) v += __shfl_xor(v, o);
    return v;
}
__device__ __forceinline__ float wave_max(float v) {
#pragma unroll
    for (int o = 1; o < 64; o <<= 1) v = fmaxf(v, __shfl_xor(v, o));
    return v;
}
__device__ __forceinline__ float sigmoidf_(float x) { return __builtin_amdgcn_rcpf(1.0f + __expf(-x)); }
__device__ __forceinline__ float siluf_(float x) { return x * __builtin_amdgcn_rcpf(1.0f + __expf(-x)); }
#define XB_TMO      128
#define XB_XCNT(j)  (256  + 64 * (j))
#define XB_XSUB(j)  (1280 + 64 * (j))
#define XB_XGEN(j)  (2304 + 64 * (j))
#define XB_TOP      3328
#define XB_TOPGEN   3392
#define XCD_BAR_WORDS 3456
#define XB_SPIN_CAP (1u << 18)

__device__ __forceinline__ unsigned xb_ld(unsigned* p)              { return __hip_atomic_load(p, __ATOMIC_RELAXED, __HIP_MEMORY_SCOPE_AGENT); }
__device__ __forceinline__ unsigned xb_add(unsigned* p, unsigned v) { return __hip_atomic_fetch_add(p, v, __ATOMIC_RELAXED, __HIP_MEMORY_SCOPE_AGENT); }
__device__ __forceinline__ unsigned xb_xcc_id() { return (unsigned)__builtin_amdgcn_s_getreg((3 << 11) | 20) & 0xFu; }
#define XB_SPIN(cond, bar) do { unsigned _sp = 0; while (cond) { __builtin_amdgcn_s_sleep(1); \
    if ((++_sp & 255u) == 0u) { if (xb_ld(&(bar)[XB_TMO])) break; if (_sp > XB_SPIN_CAP) { atomicAdd(&(bar)[XB_TMO], 1u); break; } } } } while (0)

struct XcdBarrier {
    unsigned* bar; unsigned x;
    volatile LAS unsigned* st;
};

__device__ __forceinline__ XcdBarrier xcd_barrier_post(unsigned* bar, volatile LAS unsigned* st) {
    XcdBarrier b; b.bar = bar; b.x = xb_xcc_id(); b.st = st;
    if (threadIdx.x == 0) (void)xb_add(&bar[XB_XCNT(b.x)], 1u);
    return b;
}
__device__ __forceinline__ void xcd_barrier_complete(unsigned* bar, unsigned x, unsigned& nloc, unsigned& nx) {
    const unsigned G = gridDim.x * gridDim.y * gridDim.z;
    unsigned sum, cnt, mine, sp = 0u;
    for (;;) {
        sum = 0u; cnt = 0u; mine = 0u;
#pragma unroll
        for (unsigned j = 0; j < 16; ++j) { const unsigned c = xb_ld(&bar[XB_XCNT(j)]); sum += c; cnt += (c > 0u) ? 1u : 0u; mine = (j == x) ? c : mine; }
        if (sum == G) break;
        __builtin_amdgcn_s_sleep(1);
        if ((++sp & 255u) == 0u) { if (xb_ld(&bar[XB_TMO])) break; if (sp > XB_SPIN_CAP) { atomicAdd(&bar[XB_TMO], 1u); break; } }
    }
    nloc = mine > 0u ? mine : 1u; nx = cnt > 0u ? cnt : 1u;
}

__device__ __forceinline__ void xcd_barrier(const XcdBarrier& b) {
    asm volatile("s_waitcnt vmcnt(0)" ::: "memory");
    __syncthreads();
    if (threadIdx.x == 0) {
        unsigned* bar = b.bar;
        __builtin_amdgcn_s_waitcnt(0);
        unsigned nloc = b.st[0], nx = b.st[1];
        if (nloc == 0u) { xcd_barrier_complete(bar, b.x, nloc, nx); b.st[0] = nloc; b.st[1] = nx; }
        const unsigned old = xb_add(&bar[XB_XSUB(b.x)], 1u);
        const unsigned gen = old / nloc;
        if (old + 1u == (gen + 1u) * nloc) {
            __builtin_amdgcn_fence(__ATOMIC_RELEASE, "agent");
            asm volatile("s_waitcnt vmcnt(0)" ::: "memory");
            const unsigned og = xb_add(&bar[XB_TOP], 1u);
            const unsigned tg = og / nx;
            if (og + 1u == (tg + 1u) * nx) xb_add(&bar[XB_TOPGEN], 1u);
            else XB_SPIN(xb_ld(&bar[XB_TOPGEN]) == tg, bar);
            __builtin_amdgcn_fence(__ATOMIC_ACQUIRE, "agent");
            xb_add(&bar[XB_XGEN(b.x)], 1u);
            asm volatile("s_waitcnt vmcnt(0)" ::: "memory");
        } else {
            XB_SPIN(xb_ld(&bar[XB_XGEN(b.x)]) == gen, bar);
            __builtin_amdgcn_fence(__ATOMIC_ACQUIRE, "agent");
            asm volatile("s_waitcnt vmcnt(0)" ::: "memory");
        }
    }
    __syncthreads();
}

struct Frame {
    unsigned char* lds;
    int tid, lane, wave;
    int vcu, G;
    int gw, ngw;
    const float* const __attribute__((address_space(4)))* kin;
    float* out;
    unsigned char* ws;
};
#define FW(F, off) ((F).ws + (off))
#define FIN(F, i) ((F).kin[i])

__device__ __forceinline__ void p0_transpose_item(const float* W, int K, int N, bf16* WT, int kb, int src_col0, int dst_row0, float* scr, int lane, const float* kgain = nullptr) {
    const int k0 = 64 * kb, c = lane & 7;
    v4f g0 = (v4f){1.f, 1.f, 1.f, 1.f}, g1 = g0;
    if (src_col0 >= 0) {
        float wv[32];
        if (kgain) { g0 = *(const v4f*)(kgain + k0 + 8 * c); g1 = *(const v4f*)(kgain + k0 + 8 * c + 4); }
#pragma unroll
        for (int i = 0; i < 32; ++i) { const int kk = 2 * i + (lane >> 5); wv[i] = __builtin_nontemporal_load(&W[(size_t)(k0 + kk) * N + src_col0 + (lane & 31)]); }
#pragma unroll
        for (int i = 0; i < 32; ++i) { const int kk = 2 * i + (lane >> 5); scr[kk * 33 + (lane & 31)] = wv[i]; }
    }
    __builtin_amdgcn_s_waitcnt(0xC07F); asm volatile("" ::: "memory");
#pragma unroll
    for (int j = 0; j < 4; ++j) { const int n = (lane >> 3) + 8 * j; const float* s = scr + (8 * c) * 33 + n;
        v4u o;
        if (src_col0 >= 0) { o.x = pk2(s[0 * 33] * g0.x, s[1 * 33] * g0.y); o.y = pk2(s[2 * 33] * g0.z, s[3 * 33] * g0.w); o.z = pk2(s[4 * 33] * g1.x, s[5 * 33] * g1.y); o.w = pk2(s[6 * 33] * g1.z, s[7 * 33] * g1.w); }
        else { o.x = 0u; o.y = 0u; o.z = 0u; o.w = 0u; }
        *(v4u*)(WT + (size_t)(dst_row0 + n) * K + k0 + 8 * c) = o; }
    __builtin_amdgcn_s_waitcnt(0xC07F); asm volatile("" ::: "memory");
}
template <class CM, class RM>
__device__ __forceinline__ void p0_transpose_matrix2(Frame& F, const float* W, int K, int N, bf16* WT, int nblk, CM colmap, RM rowmap, int& it0, const float* kgain = nullptr) {
    float* scr = (float*)(F.lds + RING_OFF + F.wave * 16384);
    const int nitems = (K / 64) * nblk;
    int first = (F.gw - (it0 % F.ngw) + F.ngw) % F.ngw;
    for (int r = first; r < nitems; r += F.ngw) {
        const int kb = r / nblk, nb = r % nblk;
        p0_transpose_item(W, K, N, WT, kb, colmap(nb), rowmap(nb), scr, F.lane, kgain);
    }
    it0 += nitems;
}
template <class CM>
__device__ __forceinline__ void p0_transpose_matrix(Frame& F, const float* W, int K, int N, bf16* WT, int nblk, CM colmap, int& it0, const float* kgain = nullptr) {
    float* scr = (float*)(F.lds + RING_OFF + F.wave * 16384);
    const int nitems = (K / 64) * nblk;
    int first = (F.gw - (it0 % F.ngw) + F.ngw) % F.ngw;
    for (int r = first; r < nitems; r += F.ngw) {
        const int kb = r / nblk, nb = r % nblk;
        p0_transpose_item(W, K, N, WT, kb, colmap(nb), nb * 32, scr, F.lane, kgain);
    }
    it0 += nitems;
}

#define OPQ(p) asm volatile("" : "+v"(p))
__device__ __forceinline__ void resid_phase(Frame& F, const float* xin32, const bf16* yo, const float* post_gain, bf16* XB, float* RS, float* out32) {
    for (int row = F.gw; row < MTOK; row += F.ngw) {
        v4f v[16];
        if (xin32) {
#pragma unroll
            for (int q = 0; q < 4; ++q) { const v4f* p = (const v4f*)(xin32 + (size_t)row * DM) + F.lane + 256 * q; OPQ(p);
#pragma unroll
                for (int jj = 0; jj < 4; ++jj) v[4 * q + jj] = p[64 * jj]; }
        } else {
#pragma unroll
            for (int q = 0; q < 4; ++q) { const v2u* p = (const v2u*)(XB + (size_t)row * DM) + F.lane + 256 * q; OPQ(p);
#pragma unroll
                for (int jj = 0; jj < 4; ++jj) { const v2u w = p[64 * jj]; v[4 * q + jj] = (v4f){bflo(w.x), bfhi(w.x), bflo(w.y), bfhi(w.y)}; } }
        }
        if (yo) {
            v2u y[16]; float ss = 0.f;
#pragma unroll
            for (int q = 0; q < 4; ++q) { const v2u* p = (const v2u*)(yo + (size_t)row * DM) + F.lane + 256 * q; OPQ(p);
#pragma unroll
                for (int jj = 0; jj < 4; ++jj) { const int j = 4 * q + jj; y[j] = p[64 * jj]; const float a = bflo(y[j].x), b = bfhi(y[j].x), c = bflo(y[j].y), d = bfhi(y[j].y); ss += (a * a + b * b) + (c * c + d * d); } }
            const float rstd = rsqrtf(wave_sum(ss) * (1.f / DM) + NORM_EPS);
#pragma unroll
            for (int q = 0; q < 4; ++q) { const v4f* gp = (const v4f*)post_gain + F.lane + 256 * q; OPQ(gp);
#pragma unroll
                for (int jj = 0; jj < 4; ++jj) { const int j = 4 * q + jj; const v4f g = gp[64 * jj];
                    v[j].x += bflo(y[j].x) * rstd * g.x; v[j].y += bfhi(y[j].x) * rstd * g.y; v[j].z += bflo(y[j].y) * rstd * g.z; v[j].w += bfhi(y[j].y) * rstd * g.w; } }
        }
        if (out32) {
#pragma unroll
            for (int q = 0; q < 4; ++q) { v4f* xo = (v4f*)(out32 + (size_t)row * DM) + F.lane + 256 * q; OPQ(xo);
#pragma unroll
                for (int jj = 0; jj < 4; ++jj) xo[64 * jj] = v[4 * q + jj]; }
        } else {
            float ss = 0.f;
#pragma unroll
            for (int j = 0; j < 16; ++j) ss += (v[j].x * v[j].x + v[j].y * v[j].y) + (v[j].z * v[j].z + v[j].w * v[j].w);
            const float rstd = rsqrtf(wave_sum(ss) * (1.f / DM) + NORM_EPS);
            if (F.lane == 0) RS[row] = rstd;
#pragma unroll
            for (int q = 0; q < 4; ++q) { v2u* ho = (v2u*)(XB + (size_t)row * DM) + F.lane + 256 * q; OPQ(ho);
#pragma unroll
                for (int jj = 0; jj < 4; ++jj) { const int j = 4 * q + jj; v2u o; o.x = pk2(v[j].x, v[j].y); o.y = pk2(v[j].z, v[j].w); ho[64 * jj] = o; } }
        }
    }
}

__device__ __forceinline__ void p0_prologue(Frame& F, bool split = false) {
    int it0 = 0;
    if (!split) {
    p0_transpose_matrix(F, FIN(F, 3), DM, 11360, (bf16*)FW(F, WS_W_NSA_IN), NSA_NP / 32,
        [](int nb) { const int n = nb * 32; return n < 7168 ? n : (n < 11264 ? n + 96 : (n < 11360 ? n - 4096 : -1)); }, it0, FIN(F, 1) + 0 * DM);
    p0_transpose_matrix(F, FIN(F, 7), DM, DM, (bf16*)FW(F, WS_W_NSA_OUT), DM / 32, [](int nb) { return nb * 32; }, it0);
    if (F.G != 256) p0_transpose_matrix(F, FIN(F, 8), DM, RG_NP, (bf16*)FW(F, WS_W_RG_IN), RG_NP / 32, [](int nb) { return nb * 32; }, it0, FIN(F, 1) + 1 * DM);
    p0_transpose_matrix(F, FIN(F, 14), DM, DM, (bf16*)FW(F, WS_W_RG_OUT), DM / 32, [](int nb) { return nb * 32; }, it0);
    p0_transpose_matrix(F, FIN(F, 15), DM, HG_NP, (bf16*)FW(F, WS_W_HG_IN), HG_NP / 32, [](int nb) { return nb * 32; }, it0, FIN(F, 1) + 2 * DM);
    for (int kn = 0; kn < 32; ++kn) { const int k = kn >> 4, n = kn & 15;
        p0_transpose_matrix2(F, FIN(F, 11) + (size_t)kn * 256 * 256, 256, 256, (bf16*)FW(F, WS_MISC + MISC_GATE), 8, [](int nb) { return nb * 32; },
            [=](int nb) { const int e0 = nb * 32; return (2 * n + (e0 >> 7)) * 256 + (e0 & 127) + 128 * k; }, it0); }
    for (int lw = 0; lw < 4; ++lw) {
        p0_transpose_matrix(F, FIN(F, 5) + (size_t)lw * 4096 * 128, 4096, 128, (bf16*)FW(F, WS_MISC + 4 * MiB) + (size_t)lw * 128 * 4096, 4, [](int nb) { return nb * 32; }, it0);
        p0_transpose_matrix(F, FIN(F, 6) + (size_t)lw * 128 * 128, 128, 128, (bf16*)FW(F, WS_MISC + 8 * MiB) + (size_t)lw * 128 * 128, 4, [](int nb) { return nb * 32; }, it0); }
    }
    { const int c = F.vcu * NTHREADS + F.tid;
      if (c < DM) { const float l = FIN(F, 13)[c]; ((float*)FW(F, WS_MISC + MISC_SP))[c] = (-l > 20.f) ? -l : log1pf(expf(-l)); } }
    { const int c = F.vcu * NTHREADS + F.tid;
      if (c < DM) { const float* lg = FIN(F, 16); const float a0 = lg[c], a1 = lg[DM + c], a2 = lg[2 * DM + c], a3 = lg[3 * DM + c];
          const float mx = fmaxf(fmaxf(a0, a1), fmaxf(a2, a3)); const float e0 = expf(a0 - mx), e1 = expf(a1 - mx), e2 = expf(a2 - mx), e3 = expf(a3 - mx);
          ((float*)FW(F, WS_MISC + MISC_LB))[c] = (e1 + e2) / (e0 + e1 + e2 + e3); } }
    resid_phase(F, FIN(F, 0), nullptr, nullptr, (bf16*)FW(F, WS_H), (float*)FW(F, WS_MISC + MISC_RS), nullptr);
}
constexpr int P_HG_SPLIT = 256;
__device__ __forceinline__ void p0_split_tail(Frame& F, int my, int nconv) {
    const int gw0 = F.gw, ngw0 = F.ngw; F.gw = my * NWAVES + F.wave; F.ngw = nconv * NWAVES;
    int it0 = 0;
    p0_transpose_matrix2(F, FIN(F, 15), DM, HG_NP, (bf16*)FW(F, WS_W_HG_IN), HG_NP / 32 - P_HG_SPLIT, [](int nb) { return (P_HG_SPLIT + nb) * 32; }, [](int nb) { return (P_HG_SPLIT + nb) * 32; }, it0, FIN(F, 1) + 2 * DM);
    F.gw = gw0; F.ngw = ngw0;
}
__device__ __forceinline__ void p0_post(Frame& F, unsigned* cnt) {
    asm volatile("s_waitcnt vmcnt(0)" ::: "memory"); __syncthreads();
    if (F.tid == 0) { __builtin_amdgcn_fence(__ATOMIC_RELEASE, "agent"); asm volatile("s_waitcnt vmcnt(0)" ::: "memory"); (void)xb_add(cnt, 1u); }
}
__device__ __forceinline__ void p0_split_convert(Frame& F, int my, int nconv, unsigned* flag) {
    const int gw0 = F.gw, ngw0 = F.ngw; F.gw = my * NWAVES + F.wave; F.ngw = nconv * NWAVES;
    int it0 = 0;
    auto cm = [](int nb) { const int n = nb * 32; return n < 7168 ? n : (n < 11264 ? n + 96 : (n < 11360 ? n - 4096 : -1)); };
    for (int gq = 0; gq < 2; ++gq) {
        p0_transpose_matrix2(F, FIN(F, 3), DM, 11360, (bf16*)FW(F, WS_W_NSA_IN), 32, [=](int nb) { return cm(32 * gq + nb); }, [=](int nb) { return (32 * gq + nb) * 32; }, it0, FIN(F, 1) + 0 * DM);
        p0_post(F, flag + gq); }
    p0_transpose_matrix2(F, FIN(F, 3), DM, 11360, (bf16*)FW(F, WS_W_NSA_IN), NSA_NP / 32 - 64, [=](int nb) { return cm(64 + nb); }, [=](int nb) { return (64 + nb) * 32; }, it0, FIN(F, 1) + 0 * DM);
    p0_transpose_matrix(F, FIN(F, 7), DM, DM, (bf16*)FW(F, WS_W_NSA_OUT), DM / 32, [](int nb) { return nb * 32; }, it0);
    p0_transpose_matrix(F, FIN(F, 14), DM, DM, (bf16*)FW(F, WS_W_RG_OUT), DM / 32, [](int nb) { return nb * 32; }, it0);
    p0_transpose_matrix(F, FIN(F, 15), DM, HG_NP, (bf16*)FW(F, WS_W_HG_IN), P_HG_SPLIT, [](int nb) { return nb * 32; }, it0, FIN(F, 1) + 2 * DM);
    for (int kn = 0; kn < 32; ++kn) { const int k = kn >> 4, n = kn & 15;
        p0_transpose_matrix2(F, FIN(F, 11) + (size_t)kn * 256 * 256, 256, 256, (bf16*)FW(F, WS_MISC + MISC_GATE), 8, [](int nb) { return nb * 32; },
            [=](int nb) { const int e0 = nb * 32; return (2 * n + (e0 >> 7)) * 256 + (e0 & 127) + 128 * k; }, it0); }
    for (int lw = 0; lw < 4; ++lw) {
        p0_transpose_matrix(F, FIN(F, 5) + (size_t)lw * 4096 * 128, 4096, 128, (bf16*)FW(F, WS_MISC + 4 * MiB) + (size_t)lw * 128 * 4096, 4, [](int nb) { return nb * 32; }, it0);
        p0_transpose_matrix(F, FIN(F, 6) + (size_t)lw * 128 * 128, 128, 128, (bf16*)FW(F, WS_MISC + 8 * MiB) + (size_t)lw * 128 * 128, 4, [](int nb) { return nb * 32; }, it0); }
    F.gw = gw0; F.ngw = ngw0;
}

__device__ __forceinline__ void p0_rg_in(Frame& F, int my, int nconv) {
    const int gw0 = F.gw, ngw0 = F.ngw; F.gw = my * NWAVES + F.wave; F.ngw = nconv * NWAVES;
    int it0 = 0;
    p0_transpose_matrix(F, FIN(F, 8), DM, RG_NP, (bf16*)FW(F, WS_W_RG_IN), RG_NP / 32, [](int nb) { return nb * 32; }, it0, FIN(F, 1) + 1 * DM);
    F.gw = gw0; F.ngw = ngw0;
}
__device__ __forceinline__ void p0_deferred(Frame& F, int my, int nconv, int part = -1) {
    const int gw0 = F.gw, ngw0 = F.ngw; F.gw = my * NWAVES + F.wave; F.ngw = nconv * NWAVES;
    int it0 = 0;
    if (part < 0 || part == 0) p0_transpose_matrix(F, FIN(F, 18), DM, DM, (bf16*)FW(F, WS_W_HG_OUT), DM / 32, [](int nb) { return nb * 32; }, it0);
    if (part < 0 || part == 1) p0_transpose_matrix(F, FIN(F, 3) + (size_t)DM * 11360, DM, 11360, (bf16*)FW(F, WS_W_NSA_IN) + (size_t)NSA_NP * DM, NSA_NP / 32,
        [](int nb) { const int n = nb * 32; return n < 7168 ? n : (n < 11264 ? n + 96 : (n < 11360 ? n - 4096 : -1)); }, it0, FIN(F, 1) + 3 * DM);
    if (part < 0 || part == 2) p0_transpose_matrix(F, FIN(F, 7) + (size_t)DM * DM, DM, DM, (bf16*)FW(F, WS_W_NSA_OUT) + (size_t)DM * DM, DM / 32, [](int nb) { return nb * 32; }, it0);
    F.gw = gw0; F.ngw = ngw0;
}

__device__ __forceinline__ float gelu_tanh(float x) { return 0.5f * x * (1.f + tanhf(0.7978845608028654f * (x + 0.044715f * x * x * x))); }

__device__ __forceinline__ void nsa_compress_naive(Frame& F, int j) {
    const bf16* proj = (const bf16*)FW(F, WS_PROJ);
    float* X = (float*)(F.lds);
    float* red = (float*)(F.lds + 65536);
    float* hid = (float*)(F.lds + 65536 + 8192);
    const int NU = 2 * BATCH * 128;
    for (int u = F.vcu; u < NU; u += F.G) {
        const int which = u / (BATCH * 128), b = (u / 128) % BATCH, n = u % 128;
        bf16* dst = (bf16*)FW(F, WS_SCR) + (size_t)which * (BATCH * 4 * 128 * 128);
        if (n == 127) { const int g = F.tid >> 7, e = F.tid & 127; dst[((size_t)(b * 4 + g) * 128 + n) * 128 + e] = 0; continue; }
        const float* pe = FIN(F, 4) + (size_t)(j * 2 + which) * 32 * 128;
        const float* w1 = FIN(F, 5) + (size_t)(j * 2 + which) * 4096 * 128;
        const float* w2 = FIN(F, 6) + (size_t)(j * 2 + which) * 128 * 128;
        const int col0 = which ? NSA_VC : NSA_KC;
        __syncthreads();
        for (int i = F.tid; i < 32 * 128 * 4; i += NTHREADS) { const int g = i & 3, d = (i >> 2) & 127, l = i >> 9;
            X[i] = bf2f(proj[(size_t)(b * SEQ + 16 * n + l) * NSA_NP + col0 + g * 128 + d]) + pe[l * 128 + d]; }
        __syncthreads();
        { const int e = F.tid & 127, ks = F.tid >> 7; float a0 = 0.f, a1 = 0.f, a2 = 0.f, a3 = 0.f;
          for (int l = ks * 8; l < ks * 8 + 8; ++l)
              for (int d = 0; d < 128; ++d) { const float w = w1[(size_t)(l * 128 + d) * 128 + e]; const v4f x = *(const v4f*)(X + (l * 128 + d) * 4); a0 += x.x * w; a1 += x.y * w; a2 += x.z * w; a3 += x.w * w; }
          red[(ks * 4 + 0) * 128 + e] = a0; red[(ks * 4 + 1) * 128 + e] = a1; red[(ks * 4 + 2) * 128 + e] = a2; red[(ks * 4 + 3) * 128 + e] = a3; }
        __syncthreads();
        { const int e = F.tid & 127, g = F.tid >> 7; const float s = red[(0 * 4 + g) * 128 + e] + red[(1 * 4 + g) * 128 + e] + red[(2 * 4 + g) * 128 + e] + red[(3 * 4 + g) * 128 + e]; hid[g * 128 + e] = gelu_tanh(s); }
        __syncthreads();
        { const int e2 = F.tid & 127, g = F.tid >> 7; float s = 0.f;
          for (int e = 0; e < 128; ++e) s += hid[g * 128 + e] * w2[e * 128 + e2];
          dst[((size_t)(b * 4 + g) * 128 + n) * 128 + e2] = (bf16)f2bf(s); }
    }
    __syncthreads();
}

__device__ __forceinline__ void attn_tile_naive(const float* qs, const bf16* Kb, const bf16* Vb, int ld, int lane, bool valid, float bias, float& m, float& l, float& o0, float& o1) {
    float s = 0.f;
    const v4u* kr = (const v4u*)(Kb + (size_t)lane * ld);
#pragma unroll 4
    for (int c = 0; c < 16; ++c) { const v4u w = kr[c]; const v4f qa = *(const v4f*)(qs + 8 * c), qb = *(const v4f*)(qs + 8 * c + 4);
        s += bflo(w.x) * qa.x + bfhi(w.x) * qa.y + bflo(w.y) * qa.z + bfhi(w.y) * qa.w + bflo(w.z) * qb.x + bfhi(w.z) * qb.y + bflo(w.w) * qb.z + bfhi(w.w) * qb.w; }
    s -= bias;
    const float tm = wave_max(valid ? s : -1e30f), mn = fmaxf(m, tm);
    const float p = valid ? __expf(s - mn) : 0.f, sc = __expf(m - mn);
    l = l * sc + wave_sum(p); o0 *= sc; o1 *= sc; m = mn;
#pragma unroll 8
    for (int k = 0; k < 64; ++k) { const float pk = __shfl(p, k); const unsigned vv = *(const unsigned*)(Vb + (size_t)k * ld + 2 * lane); o0 += pk * bflo(vv); o1 += pk * bfhi(vv); }
}

__device__ __forceinline__ void nsa_attn_naive(Frame& F) {
    const bf16* proj = (const bf16*)FW(F, WS_PROJ);
    const bf16* KC = (const bf16*)FW(F, WS_SCR); const bf16* VC = KC + (size_t)BATCH * 4 * 128 * 128;
    bf16* Y = (bf16*)FW(F, WS_Y);
    float* qsm = (float*)(F.lds);
    float* pc = (float*)(F.lds + 4096);
    float* pg = (float*)(F.lds + 8192);
    unsigned* msk = (unsigned*)(F.lds + 8192 + 512);
    const int jh = F.wave, lane = F.lane;
    const float scale = 0.08838834764831845f;
    for (int u = F.vcu; u < BATCH * 4 * SEQ; u += F.G) {
        const int t = u % SEQ, g = (u / SEQ) & 3, b = u / (4 * SEQ);
        const int h = g * 8 + jh; const float slope = exp2f(-8.0f * (float)(h + 1) / 32.0f);
        const size_t rowq = (size_t)(b * SEQ + t) * NSA_NP;
        float* qs = qsm + jh * 128;
        __syncthreads();
        { const unsigned w = *(const unsigned*)(proj + rowq + NSA_Q + h * 128 + 2 * lane); qs[2 * lane] = bflo(w) * scale; qs[2 * lane + 1] = bfhi(w) * scale; }
        __builtin_amdgcn_s_waitcnt(0xC07F); asm volatile("" ::: "memory");
        float oc0 = 0.f, oc1 = 0.f;
        {
            const bf16* kc = KC + (size_t)(b * 4 + g) * 128 * 128; const bf16* vc = VC + (size_t)(b * 4 + g) * 128 * 128;
            float s[2]; bool vd[2];
#pragma unroll
            for (int hh = 0; hh < 2; ++hh) { const int n = lane + 64 * hh; float a = 0.f; const v4u* kr = (const v4u*)(kc + (size_t)n * 128);
#pragma unroll 4
                for (int c = 0; c < 16; ++c) { const v4u w = kr[c]; const v4f qa = *(const v4f*)(qs + 8 * c), qb = *(const v4f*)(qs + 8 * c + 4);
                    a += bflo(w.x) * qa.x + bfhi(w.x) * qa.y + bflo(w.y) * qa.z + bfhi(w.y) * qa.w + bflo(w.z) * qb.x + bfhi(w.z) * qb.y + bflo(w.w) * qb.z + bfhi(w.w) * qb.w; }
                const int dist = t - (16 * n + 31); vd[hh] = (n < 127) && dist >= 0; s[hh] = a - slope * (float)dist; }
            const float mx = wave_max(fmaxf(vd[0] ? s[0] : -1e30f, vd[1] ? s[1] : -1e30f));
            float p0 = vd[0] ? __expf(s[0] - mx) : 0.f, p1 = vd[1] ? __expf(s[1] - mx) : 0.f;
            const float lsum = wave_sum(p0 + p1), inv = lsum > 0.f ? 1.0f / lsum : 0.f;
            p0 *= inv; p1 *= inv;
            pc[jh * 128 + lane] = p0; pc[jh * 128 + 64 + lane] = p1;
#pragma unroll 8
            for (int k = 0; k < 64; ++k) { const float pk = __shfl(p0, k); const unsigned vv = *(const unsigned*)(vc + (size_t)k * 128 + 2 * lane); oc0 += pk * bflo(vv); oc1 += pk * bfhi(vv); }
#pragma unroll 8
            for (int k = 0; k < 64; ++k) { const float pk = __shfl(p1, k); const unsigned vv = *(const unsigned*)(vc + (size_t)(k + 64) * 128 + 2 * lane); oc0 += pk * bflo(vv); oc1 += pk * bfhi(vv); }
        }
        __syncthreads();
        if (F.tid < 128) { float a = 0.f;
#pragma unroll
            for (int q = 0; q < 8; ++q) a += pc[q * 128 + F.tid];
            pg[F.tid] = (F.tid < 127) ? a : 0.f; }
        __syncthreads();
        const int cur = t >> 6;
        if (F.wave == 0) {
            float sc = -3e38f;
            if (lane < 32) { const int c0 = 4 * lane; float ps = 2.f * (pg[c0] + pg[c0 + 1] + pg[c0 + 2]) + pg[c0 + 3]; if (lane > 0) ps += pg[c0 - 1];
                sc = (lane == 0 || lane == cur || lane == cur - 1) ? 1e6f : (lane > cur ? -1.0f : ps); }
            unsigned mask = 0u; bool taken = false;
            for (int it = 0; it < 16; ++it) { const float v = taken ? -3e38f : sc; const float mx = wave_max(v);
                const unsigned long long bal = __ballot(v == mx && !taken && lane < 32); const int sel = __ffsll((long long)bal) - 1;
                mask |= 1u << sel; if (lane == sel) taken = true; }
            if (lane == 0) msk[0] = mask;
        }
        __syncthreads();
        const unsigned mask = msk[0];
        float ms = -1e30f, ls = 0.f, os0 = 0.f, os1 = 0.f;
        for (int kb = 0; kb <= cur; ++kb) { if (!((mask >> kb) & 1u)) continue;
            const int kp = kb * 64 + lane; const size_t r0 = (size_t)(b * SEQ + kb * 64) * NSA_NP;
            attn_tile_naive(qs, proj + r0 + NSA_KS + g * 128, proj + r0 + NSA_VS + g * 128, NSA_NP, lane, kp <= t, slope * (float)(t - kp), ms, ls, os0, os1); }
        float mw = -1e30f, lw = 0.f, ow0 = 0.f, ow1 = 0.f;
        { const int lo = t - 511 > 0 ? t - 511 : 0;
          for (int kb = lo >> 6; kb <= cur; ++kb) { const int kp = kb * 64 + lane; const size_t r0 = (size_t)(b * SEQ + kb * 64) * NSA_NP;
              attn_tile_naive(qs, proj + r0 + NSA_KW + g * 128, proj + r0 + NSA_VW + g * 128, NSA_NP, lane, kp <= t && kp >= lo, slope * (float)(t - kp), mw, lw, ow0, ow1); } }
        const float g0 = sigmoidf_(bf2f(proj[rowq + NSA_GL + 0 * 32 + h])), g1 = sigmoidf_(bf2f(proj[rowq + NSA_GL + 1 * 32 + h])), g2 = sigmoidf_(bf2f(proj[rowq + NSA_GL + 2 * 32 + h]));
        const float is = 1.0f / ls, iw = 1.0f / lw;
        const unsigned zw = *(const unsigned*)(proj + rowq + NSA_Z + h * 128 + 2 * lane);
        const float y0 = (g0 * oc0 + g1 * os0 * is + g2 * ow0 * iw) * siluf_(bflo(zw)), y1 = (g0 * oc1 + g1 * os1 * is + g2 * ow1 * iw) * siluf_(bfhi(zw));
        *(unsigned*)(Y + (size_t)(b * SEQ + t) * DM + h * 128 + 2 * lane) = pk2(y0, y1);
    }
    __syncthreads();
}

__device__ __forceinline__ void rg_gates_naive(Frame& F) {
    const bf16* proj = (const bf16*)FW(F, WS_PROJ);
    float* A = (float*)FW(F, WS_SCR); float* U = (float*)FW(F, WS_SCR + 128 * MiB);
    const float* conv_w = FIN(F, 9); const float* conv_b = FIN(F, 10); const float* gate_w = FIN(F, 11); const float* gate_b = FIN(F, 12); const float* lam = FIN(F, 13);
    float* xT = (float*)(F.lds);
    float* gt = (float*)(F.lds + 8192);
    const int NU = (MTOK / 8) * 16;
    for (int u = F.vcu; u < NU; u += F.G) {
        const int n = u & 15, tb = u >> 4, row0 = tb * 8;
        __syncthreads();
        for (int i = F.tid; i < 2048; i += NTHREADS) { const int c = i & 255, tk = i >> 8, ch = n * 256 + c, row = row0 + tk, tpos = row % SEQ;
            float a = conv_b[ch];
#pragma unroll
            for (int k4 = 0; k4 < 4; ++k4) { const int tp = tpos - 3 + k4; if (tp >= 0) a += conv_w[k4 * DM + ch] * bf2f(proj[(size_t)(row - 3 + k4) * RG_NP + ch]); }
            xT[c * 8 + tk] = a; }
        __syncthreads();
        { const int k = F.tid >> 8, e = F.tid & 255; float acc[8]; const float bb = gate_b[(k * 16 + n) * 256 + e];
#pragma unroll
          for (int q = 0; q < 8; ++q) acc[q] = bb;
          const float* wp = gate_w + ((size_t)(k * 16 + n) * 256) * 256 + e;
#pragma unroll 4
          for (int c = 0; c < 256; ++c) { const float w = wp[(size_t)c * 256]; const v4f x0 = *(const v4f*)(xT + c * 8), x1 = *(const v4f*)(xT + c * 8 + 4);
              acc[0] += x0.x * w; acc[1] += x0.y * w; acc[2] += x0.z * w; acc[3] += x0.w * w; acc[4] += x1.x * w; acc[5] += x1.y * w; acc[6] += x1.z * w; acc[7] += x1.w * w; }
#pragma unroll
          for (int q = 0; q < 8; ++q) gt[(k * 8 + q) * 256 + e] = sigmoidf_(acc[q]); }
        __syncthreads();
        for (int i = F.tid; i < 2048; i += NTHREADS) { const int c = i & 255, tk = i >> 8, ch = n * 256 + c, row = row0 + tk, tpos = row % SEQ;
            const float ig = gt[(0 * 8 + tk) * 256 + c], rg = gt[(1 * 8 + tk) * 256 + c];
            const float l = lam[ch]; const float sp = (-l > 20.f) ? -l : log1pf(expf(-l));
            const float log_a = -8.0f * rg * sp; const float a = expf(log_a);
            const float mult = tpos == 0 ? 1.0f : sqrtf(-expm1f(2.0f * log_a));
            A[(size_t)row * DM + ch] = a; U[(size_t)row * DM + ch] = mult * ig * xT[c * 8 + tk]; }
    }
    __syncthreads();
}
__device__ __forceinline__ void rg_scan(Frame& F) {
    const bf16* proj = (const bf16*)FW(F, WS_PROJ);
    const unsigned* AU = (const unsigned*)FW(F, WS_SCR);
    bf16* Y = (bf16*)FW(F, WS_Y);
    v2f* PP = (v2f*)(F.lds); v2f* HH = (v2f*)(F.lds + 4096);
    for (int u = F.vcu; u < BATCH * 64; u += F.G) {
        const int b = u >> 6, cp = F.tid & 31, ch = (u & 63) * 64 + 2 * cp, seg = F.tid >> 5;
        const size_t base = (size_t)(b * SEQ + seg * 128) * DM + ch;
        float P0 = 1.f, P1 = 1.f, H0 = 0.f, H1 = 0.f;
#pragma unroll 32
        for (int s = 0; s < 128; ++s) { const v2u w = *(const v2u*)(AU + base + (size_t)s * DM); const float a0 = 1.0f - bflo(w.x), a1 = 1.0f - bflo(w.y);
            H0 = a0 * H0 + bfhi(w.x); H1 = a1 * H1 + bfhi(w.y); P0 *= a0; P1 *= a1; }
        __syncthreads();
        PP[seg * 32 + cp] = (v2f){P0, P1}; HH[seg * 32 + cp] = (v2f){H0, H1};
        __syncthreads();
        float h0 = 0.f, h1 = 0.f;
        for (int s2 = 0; s2 < seg; ++s2) { const v2f p = PP[s2 * 32 + cp], hh = HH[s2 * 32 + cp]; h0 = p.x * h0 + hh.x; h1 = p.y * h1 + hh.y; }
        const size_t zb = (size_t)(b * SEQ + seg * 128) * RG_NP + 4096 + ch;
        for (int s0 = 0; s0 < 128; s0 += 32) {
            v2u wv[32]; unsigned zv[32];
#pragma unroll
            for (int i = 0; i < 32; ++i) { wv[i] = *(const v2u*)(AU + base + (size_t)(s0 + i) * DM); zv[i] = *(const unsigned*)(proj + zb + (size_t)(s0 + i) * RG_NP); }
#pragma unroll
            for (int i = 0; i < 32; ++i) { const v2u w = wv[i]; h0 = (1.0f - bflo(w.x)) * h0 + bfhi(w.x); h1 = (1.0f - bflo(w.y)) * h1 + bfhi(w.y);
                const unsigned z = zv[i]; *(unsigned*)(Y + base + (size_t)(s0 + i) * DM) = pk2(h0 * siluf_(bflo(z)), h1 * siluf_(bfhi(z))); }
        }
    }
    __syncthreads();
}

__device__ __forceinline__ void hg_naive(Frame& F) {
    const bf16* proj = (const bf16*)FW(F, WS_PROJ);
    const float* LB = (const float*)FW(F, WS_MISC + MISC_LB); const float* gain = FIN(F, 17);
    bf16* Y = (bf16*)FW(F, WS_Y);
    float* st = (float*)(F.lds);
    float* part = (float*)(F.lds + 8192);
    for (int u = F.vcu; u < BATCH * 32; u += F.G) {
        const int b = u >> 5, hd = u & 31, v = F.tid & 127, dg = F.tid >> 7;
        float S[32];
#pragma unroll
        for (int i = 0; i < 32; ++i) S[i] = 0.f;
        const float lb = (F.tid < 128) ? LB[hd * 128 + F.tid] : 0.f;
        const float gn = gain[v];
        __syncthreads();
        { const size_t r = (size_t)(b * SEQ) * HG_NP; float* s0 = st;
          if (F.tid < 128) { const float q = bf2f(proj[r + hd * 128 + F.tid]), fr = bf2f(proj[r + 4096 + hd * 128 + F.tid]); const float f = lb + (1.f - lb) * sigmoidf_(fr);
              s0[F.tid] = siluf_(q); s0[128 + F.tid] = f; s0[256 + F.tid] = 1.f - f; }
          else if (F.tid < 256) s0[384 + F.tid - 128] = bf2f(proj[r + 8192 + hd * 128 + F.tid - 128]);
          else if (F.tid < 384) s0[512 + F.tid - 256] = bf2f(proj[r + 12288 + hd * 128 + F.tid - 256]); }
        __syncthreads();
        for (int t = 0; t < SEQ; ++t) {
            float* sc = st + (t & 1) * 640; float* sn = st + ((t + 1) & 1) * 640;
            float r0 = 0.f, r1 = 0.f;
            if (t + 1 < SEQ) { const size_t r = (size_t)(b * SEQ + t + 1) * HG_NP;
                if (F.tid < 128) { r0 = bf2f(proj[r + hd * 128 + F.tid]); r1 = bf2f(proj[r + 4096 + hd * 128 + F.tid]); }
                else if (F.tid < 256) r0 = bf2f(proj[r + 8192 + hd * 128 + F.tid - 128]);
                else if (F.tid < 384) r0 = bf2f(proj[r + 12288 + hd * 128 + F.tid - 256]); }
            const float vv = sc[384 + v]; float p = 0.f;
#pragma unroll
            for (int i4 = 0; i4 < 8; ++i4) { const v4f qv = *(const v4f*)(sc + dg * 32 + 4 * i4), fv = *(const v4f*)(sc + 128 + dg * 32 + 4 * i4), kv = *(const v4f*)(sc + 256 + dg * 32 + 4 * i4);
                S[4 * i4 + 0] = fv.x * S[4 * i4 + 0] + kv.x * vv; p += qv.x * S[4 * i4 + 0];
                S[4 * i4 + 1] = fv.y * S[4 * i4 + 1] + kv.y * vv; p += qv.y * S[4 * i4 + 1];
                S[4 * i4 + 2] = fv.z * S[4 * i4 + 2] + kv.z * vv; p += qv.z * S[4 * i4 + 2];
                S[4 * i4 + 3] = fv.w * S[4 * i4 + 3] + kv.w * vv; p += qv.w * S[4 * i4 + 3]; }
            part[dg * 128 + v] = p;
            if (t + 1 < SEQ) {
                if (F.tid < 128) { const float f = lb + (1.f - lb) * sigmoidf_(r1); sn[F.tid] = siluf_(r0); sn[128 + F.tid] = f; sn[256 + F.tid] = 1.f - f; }
                else if (F.tid < 256) sn[384 + F.tid - 128] = r0;
                else if (F.tid < 384) sn[512 + F.tid - 256] = r0; }
            __syncthreads();
            if (F.wave == 0) { const int v0 = F.lane, v1 = F.lane + 64;
                const float o0 = part[v0] + part[128 + v0] + part[256 + v0] + part[384 + v0], o1 = part[v1] + part[128 + v1] + part[256 + v1] + part[384 + v1];
                const float rstd = rsqrtf(wave_sum(o0 * o0 + o1 * o1) * (1.f / 128.f) + NORM_EPS);
                const size_t yo = (size_t)(b * SEQ + t) * DM + hd * 128;
                Y[yo + v0] = (bf16)f2bf(o0 * rstd * gain[v0] * siluf_(sc[512 + v0])); Y[yo + v1] = (bf16)f2bf(o1 * rstd * gain[v1] * siluf_(sc[512 + v1])); }
            __syncthreads();
        }
        (void)gn;
    }
    __syncthreads();
}

namespace at {
using bf16x8 = __attribute__((ext_vector_type(8))) short;
using s16x4  = __attribute__((ext_vector_type(4))) short;
using f32x16 = __attribute__((ext_vector_type(16))) float;
using u32x4  = __attribute__((ext_vector_type(4))) unsigned;
constexpr int SHM_V = 64 * 128 * 2, SHM_K = 64 * 128 * 2;
#define KSWZ(row, colB) ((row) * 256 + ((colB) ^ (((row) & 7) << 4)))
#define SBAR() __builtin_amdgcn_sched_barrier(0)
__device__ __forceinline__ int crow(int r, int hi) { return (r & 3) + 8 * (r >> 2) + 4 * hi; }
__device__ __forceinline__ unsigned cvtpk(float lo, float hi) { unsigned r; asm volatile("v_cvt_pk_bf16_f32 %0, %1, %2" : "=v"(r) : "v"(lo), "v"(hi)); return r; }
__device__ __forceinline__ void qkt(f32x16& p0, f32x16& p1, const char* Ks, const bf16x8* qr, int r32, int hi) {
  p0 = f32x16{}; p1 = f32x16{};
#pragma unroll
  for (int d0 = 0; d0 < 8; ++d0) { int cb = (d0 * 16 + hi * 8) * 2;
    bf16x8 b0 = *reinterpret_cast<const bf16x8*>(Ks + KSWZ(r32, cb));
    bf16x8 b1 = *reinterpret_cast<const bf16x8*>(Ks + KSWZ(32 + r32, cb));
    p0 = __builtin_amdgcn_mfma_f32_32x32x16_bf16(b0, qr[d0], p0, 0, 0, 0);
    p1 = __builtin_amdgcn_mfma_f32_32x32x16_bf16(b1, qr[d0], p1, 0, 0, 0); }
}
__device__ __forceinline__ int v_st(int k, int c) { const int kk = (k & ~0xC) | ((k & 4) << 1) | ((k & 8) >> 1); return ((kk >> 3) * 4 + (c >> 5)) * 512 + ((kk & 7) * 32 + (c & 31)) * 2; }
__device__ __forceinline__ int v_rd_base(int lane) { return ((lane & 3) << 3) | (((lane >> 2) & 3) << 6) | (((lane >> 4) & 1) << 5) | (((lane >> 5) & 1) << 8); }
constexpr int v_rd_off(int d0, int ks, int half) { return d0 * 512 + ks * 4096 + half * 2048; }
template <int OFF> __device__ __forceinline__ s16x4 tr_read(int vb) {
  s16x4 r; asm volatile("ds_read_b64_tr_b16 %0, %1 offset:%2" : "=&v"(r) : "v"(vb), "i"(OFF) : "memory"); return r;
}
template <int D0> __device__ __forceinline__ void pv_one(f32x16& od, int vb, bf16x8 pa0, bf16x8 pa1, bf16x8 pa2, bf16x8 pa3) {
  const s16x4 l0 = tr_read<v_rd_off(D0, 0, 0)>(vb), h0 = tr_read<v_rd_off(D0, 0, 1)>(vb), l1 = tr_read<v_rd_off(D0, 1, 0)>(vb), h1 = tr_read<v_rd_off(D0, 1, 1)>(vb);
  const s16x4 l2 = tr_read<v_rd_off(D0, 2, 0)>(vb), h2 = tr_read<v_rd_off(D0, 2, 1)>(vb), l3 = tr_read<v_rd_off(D0, 3, 0)>(vb), h3 = tr_read<v_rd_off(D0, 3, 1)>(vb);
  asm volatile("s_waitcnt lgkmcnt(0)" ::: "memory"); SBAR();
#define PK(L, H) (bf16x8){L[0], L[1], L[2], L[3], H[0], H[1], H[2], H[3]}
  od = __builtin_amdgcn_mfma_f32_32x32x16_bf16(pa0, PK(l0, h0), od, 0, 0, 0);
  od = __builtin_amdgcn_mfma_f32_32x32x16_bf16(pa1, PK(l1, h1), od, 0, 0, 0);
  od = __builtin_amdgcn_mfma_f32_32x32x16_bf16(pa2, PK(l2, h2), od, 0, 0, 0);
  od = __builtin_amdgcn_mfma_f32_32x32x16_bf16(pa3, PK(l3, h3), od, 0, 0, 0);
#undef PK
}
#define PV_RD(D0, L0, H0, L1, H1, L2, H2, L3, H3) do { L0 = tr_read<v_rd_off(D0, 0, 0)>(vb); H0 = tr_read<v_rd_off(D0, 0, 1)>(vb); L1 = tr_read<v_rd_off(D0, 1, 0)>(vb); H1 = tr_read<v_rd_off(D0, 1, 1)>(vb); \
    L2 = tr_read<v_rd_off(D0, 2, 0)>(vb); H2 = tr_read<v_rd_off(D0, 2, 1)>(vb); L3 = tr_read<v_rd_off(D0, 3, 0)>(vb); H3 = tr_read<v_rd_off(D0, 3, 1)>(vb); } while (0)
#define PV_PK(L, H) (bf16x8){L[0], L[1], L[2], L[3], H[0], H[1], H[2], H[3]}
#define PV_MM(OD, L0, H0, L1, H1, L2, H2, L3, H3) do { OD = __builtin_amdgcn_mfma_f32_32x32x16_bf16(pa0, PV_PK(L0, H0), OD, 0, 0, 0); OD = __builtin_amdgcn_mfma_f32_32x32x16_bf16(pa1, PV_PK(L1, H1), OD, 0, 0, 0); \
    OD = __builtin_amdgcn_mfma_f32_32x32x16_bf16(pa2, PV_PK(L2, H2), OD, 0, 0, 0); OD = __builtin_amdgcn_mfma_f32_32x32x16_bf16(pa3, PV_PK(L3, H3), OD, 0, 0, 0); } while (0)
__device__ __forceinline__ void pv_d0(f32x16* o, int vb, bf16x8 pa0, bf16x8 pa1, bf16x8 pa2, bf16x8 pa3) {
  s16x4 al0, ah0, al1, ah1, al2, ah2, al3, ah3, bl0, bh0, bl1, bh1, bl2, bh2, bl3, bh3;
  PV_RD(0, al0, ah0, al1, ah1, al2, ah2, al3, ah3);
  PV_RD(1, bl0, bh0, bl1, bh1, bl2, bh2, bl3, bh3);
  asm volatile("s_waitcnt lgkmcnt(8)" ::: "memory"); SBAR();
  PV_MM(o[0], al0, ah0, al1, ah1, al2, ah2, al3, ah3); SBAR();
  PV_RD(2, al0, ah0, al1, ah1, al2, ah2, al3, ah3);
  asm volatile("s_waitcnt lgkmcnt(8)" ::: "memory"); SBAR();
  PV_MM(o[1], bl0, bh0, bl1, bh1, bl2, bh2, bl3, bh3); SBAR();
  PV_RD(3, bl0, bh0, bl1, bh1, bl2, bh2, bl3, bh3);
  asm volatile("s_waitcnt lgkmcnt(8)" ::: "memory"); SBAR();
  PV_MM(o[2], al0, ah0, al1, ah1, al2, ah2, al3, ah3); SBAR();
  asm volatile("s_waitcnt lgkmcnt(0)" ::: "memory"); SBAR();
  PV_MM(o[3], bl0, bh0, bl1, bh1, bl2, bh2, bl3, bh3);
}
template <int CTRL> __device__ __forceinline__ float dppx(float x) { return __builtin_bit_cast(float, __builtin_amdgcn_mov_dpp(__builtin_bit_cast(int, x), CTRL, 0xf, 0xf, true)); }
__device__ __forceinline__ float swapmax(float x) { auto rr = __builtin_amdgcn_permlane32_swap(__float_as_uint(x), __float_as_uint(x), false, false); return fmaxf(__uint_as_float(rr[0]), __uint_as_float(rr[1])); }
__device__ __forceinline__ float swapsum(float x) { auto rr = __builtin_amdgcn_permlane32_swap(__float_as_uint(x), __float_as_uint(x), false, false); return __uint_as_float(rr[0]) + __uint_as_float(rr[1]); }
#define PK4(P, BASE, OUT) do { unsigned a0 = cvtpk(P[BASE + 0], P[BASE + 1]), a1 = cvtpk(P[BASE + 2], P[BASE + 3]);   \
    unsigned b0 = cvtpk(P[BASE + 4], P[BASE + 5]), b1 = cvtpk(P[BASE + 6], P[BASE + 7]);                              \
    auto r0 = __builtin_amdgcn_permlane32_swap(a0, b0, false, false); auto r1 = __builtin_amdgcn_permlane32_swap(a1, b1, false, false); \
    u32x4 w = {r0[0], r1[0], r0[1], r1[1]}; OUT = *reinterpret_cast<bf16x8*>(&w); } while (0)

constexpr float LOG2E = 1.4426950408889634f;
constexpr float CSC = 0.088388347648318440f * LOG2E;
constexpr float THR2 = 8.0f * LOG2E;

__device__ __forceinline__ void score_xform(f32x16& p0, f32x16& p1, float sl, float base, bool mask, int kp0, int t, int tlo) {
  const float s2_ = sl + sl, s4_ = s2_ + s2_, s8_ = s4_ + s4_;
  const float a_[4] = {0.f, sl, s2_, s2_ + sl};
  float b_[8]; b_[0] = base;
#pragma unroll
  for (int q = 1; q < 8; ++q) b_[q] = b_[q - 1] + s8_;
#pragma unroll
  for (int r = 0; r < 16; ++r) { p0[r] = fmaf(p0[r], CSC, a_[r & 3] + b_[r >> 2]); p1[r] = fmaf(p1[r], CSC, a_[r & 3] + b_[4 + (r >> 2)]); }
  if (mask) {
    const int dhi = t - kp0, dlo = tlo - kp0;
#pragma unroll
    for (int r = 0; r < 16; ++r) { const int c = (r & 3) + 8 * (r >> 2);
      p0[r] = (c > dhi || c < dlo) ? -1e30f : p0[r]; p1[r] = (c + 32 > dhi || c + 32 < dlo) ? -1e30f : p1[r]; } }
}
__device__ __forceinline__ void softmax_step(f32x16& p0, f32x16& p1, float& m, float& l, float& alpha, bf16x8& pa0, bf16x8& pa1, bf16x8& pa2, bf16x8& pa3) {
  float pmax = p0[0];
#pragma unroll
  for (int r = 1; r < 16; ++r) pmax = fmaxf(pmax, p0[r]);
#pragma unroll
  for (int r = 0; r < 16; ++r) pmax = fmaxf(pmax, p1[r]);
  pmax = swapmax(pmax);
  if (__all(pmax - m <= THR2)) { alpha = 1.f; }
  else { const float mn = fmaxf(m, pmax); alpha = __builtin_amdgcn_exp2f(m - mn); m = mn; }
  float ps = 0.f;
#pragma unroll
  for (int r = 0; r < 16; ++r) { p0[r] = __builtin_amdgcn_exp2f(p0[r] - m); ps += p0[r]; }
#pragma unroll
  for (int r = 0; r < 16; ++r) { p1[r] = __builtin_amdgcn_exp2f(p1[r] - m); ps += p1[r]; }
  ps = swapsum(ps);
  l = l * alpha + ps;
  PK4(p0, 0, pa0); PK4(p0, 8, pa1); PK4(p1, 0, pa2); PK4(p1, 8, pa3);
}
}

constexpr int AT_K = 0  , AT_V = 32768  , AT_OT = 81920  , AT_WS = 147456  , AT_SC = AT_WS + 2048  , AT_MK = AT_SC + 4096  ;
static_assert(AT_MK + 256 <= MISC_OFF, "attention LDS map below the barrier words");

template <int VAR>
__device__ __forceinline__ void nsa_attn_mfma(Frame& F, bf16* Y) {
  using namespace at;
  const bf16* proj = (const bf16*)FW(F, WS_PROJ);
  const bf16* KC = (const bf16*)FW(F, WS_SCR); const bf16* VC = KC + (size_t)BATCH * 4 * 128 * 128;
  unsigned char* lds = F.lds;
  char* V_lds = (char*)lds + AT_V; char* K_lds = (char*)lds + AT_K;
  const int tid = F.tid, wid = F.wave;
  float* wsf = (float*)(lds + AT_WS) + wid * 64;
  float* scl = (float*)(lds + AT_SC); unsigned* mkl = (unsigned*)(lds + AT_MK);

#define TDMA(Kp, Vp, ldE, kbuf_, vbuf_) do { \
    LAS unsigned char* kd_ = (LAS unsigned char*)lds + AT_K + (kbuf_) * SHM_K + wid * 1024; LAS unsigned char* vd_ = (LAS unsigned char*)lds + AT_V + (vbuf_) * SHM_V + wid * 1024; \
    __builtin_amdgcn_global_load_lds((const unsigned*)(Kp), (LAS unsigned*)kd_, 16, 0, 0); __builtin_amdgcn_global_load_lds((const unsigned*)((Kp) + (size_t)32 * (ldE)), (LAS unsigned*)(kd_ + 8192), 16, 0, 0); \
    __builtin_amdgcn_global_load_lds((const unsigned*)(Vp), (LAS unsigned*)vd_, 16, 0, 0); __builtin_amdgcn_global_load_lds((const unsigned*)((Vp) + (size_t)32 * (ldE)), (LAS unsigned*)(vd_ + 8192), 16, 0, 0); } while (0)
#define TWAIT() do { asm volatile("s_waitcnt vmcnt(0)" ::: "memory"); __syncthreads(); } while (0)
#define RESC(a) do { if (__any((a) < 1.f)) { if (hi == 0) al_l[r32] = (a); asm volatile("s_waitcnt lgkmcnt(0)" ::: "memory"); \
    _Pragma("unroll") for (int d = 0; d < 4; ++d) _Pragma("unroll") for (int r = 0; r < 16; ++r) o[d][r] *= al_l[crow(r, hi)]; asm volatile("s_waitcnt lgkmcnt(0)" ::: "memory"); } } while (0)
#define FOLD(fval, FIRST) do { if (hi == 0) li_l[r32] = (fval); asm volatile("s_waitcnt lgkmcnt(0)" ::: "memory"); \
    _Pragma("unroll") for (int r = 0; r < 16; r += 2) { const float fa_ = li_l[crow(r, hi)], fb_ = li_l[crow(r + 1, hi)]; \
      v4u w_; if (!(FIRST)) w_ = otl[(r >> 1) * 512]; else { w_.x = 0u; w_.y = 0u; w_.z = 0u; w_.w = 0u; } \
      w_.x = cvtpk(bflo(w_.x) + o[0][r] * fa_, bfhi(w_.x) + o[0][r + 1] * fb_); w_.y = cvtpk(bflo(w_.y) + o[1][r] * fa_, bfhi(w_.y) + o[1][r + 1] * fb_); \
      w_.z = cvtpk(bflo(w_.z) + o[2][r] * fa_, bfhi(w_.z) + o[2][r + 1] * fb_); w_.w = cvtpk(bflo(w_.w) + o[3][r] * fa_, bfhi(w_.w) + o[3][r + 1] * fb_); \
      otl[(r >> 1) * 512] = w_; } \
    asm volatile("s_waitcnt lgkmcnt(0)" ::: "memory"); } while (0)
#define FOLDL(fval) do { if (hi == 0) li_l[r32] = (fval); asm volatile("s_waitcnt lgkmcnt(0)" ::: "memory"); \
    _Pragma("unroll") for (int r = 0; r < 16; r += 2) { const float fa_ = li_l[crow(r, hi)], fb_ = li_l[crow(r + 1, hi)]; \
      v4u w_ = otl[(r >> 1) * 512]; \
      w_.x = cvtpk(bflo(w_.x) + o[0][r] * fa_, bfhi(w_.x) + o[0][r + 1] * fb_); w_.y = cvtpk(bflo(w_.y) + o[1][r] * fa_, bfhi(w_.y) + o[1][r + 1] * fb_); \
      w_.z = cvtpk(bflo(w_.z) + o[2][r] * fa_, bfhi(w_.z) + o[2][r + 1] * fb_); w_.w = cvtpk(bflo(w_.w) + o[3][r] * fa_, bfhi(w_.w) + o[3][r + 1] * fb_); \
      unsigned short* ra_ = rowst + ((r & 3) + 8 * (r >> 2)) * ROWP; unsigned short* rb_ = ra_ + ROWP; \
      ra_[0] = (unsigned short)w_.x; rb_[0] = (unsigned short)(w_.x >> 16); ra_[32] = (unsigned short)w_.y; rb_[32] = (unsigned short)(w_.y >> 16); \
      ra_[64] = (unsigned short)w_.z; rb_[64] = (unsigned short)(w_.z >> 16); ra_[96] = (unsigned short)w_.w; rb_[96] = (unsigned short)(w_.w >> 16); } \
    asm volatile("s_waitcnt lgkmcnt(0)" ::: "memory"); } while (0)

  for (int uu = F.vcu * 4; uu < 1024; uu += (uu % 4 == 3) ? (F.G - 1) * 4 + 1 : 1) {
    const int ui = uu & 3;
    int lane = F.lane; asm volatile("" : "+v"(lane));
    const int r32 = lane & 31, hi = lane >> 5, tsub = r32 >> 3, j = r32 & 7, tl_ = wid * 64 + lane;
    const int krow = tl_ >> 4, kcol = ((lane & 15) ^ (krow & 7)) * 8;
    const int vkk = (wid >> 1) * 8 + ((lane >> 2) & 7), vrow = (vkk & ~0xC) | ((vkk & 4) << 1) | ((vkk & 8) >> 1), vcol = ((wid & 1) * 2 + (lane >> 5)) * 32 + (lane & 3) * 8;
    const int vb0 = (int)(uintptr_t)((LAS unsigned char*)lds + AT_V) + v_rd_base(lane);
    float* li_l = wsf; float* al_l = wsf + 32;
    v4u* otl = (v4u*)(lds + AT_OT) + tl_;
    constexpr int ROWP = 136;
    unsigned short* rowst = (unsigned short*)(lds + AT_K) + (wid * 32 + 4 * hi) * ROWP + r32;
    const int wg = uu >> 2, b = wg >> 6, kq_ = wg & 63, k32_ = (kq_ + 32) & 63;
    const int g = ui, qb = (ui == 0) ? kq_ : (ui == 1) ? 63 - kq_ : (ui == 2) ? k32_ : 63 - k32_;
    const int t0 = qb * 32, cur = t0 >> 6;
    const int t = t0 + 4 * wid + tsub, h = g * 8 + j;
    const float slope2 = exp2f(-0.25f * (float)(h + 1)) * LOG2E;
    const size_t rowq = (size_t)(b * SEQ + t) * NSA_NP;
    bf16x8 qr[8];
#pragma unroll
    for (int d0 = 0; d0 < 8; ++d0) qr[d0] = *(const bf16x8*)(proj + rowq + NSA_Q + h * 128 + d0 * 16 + hi * 8);
    const float g0 = sigmoidf_(bf2f(proj[rowq + NSA_GL + 0 * 32 + h])), g1 = sigmoidf_(bf2f(proj[rowq + NSA_GL + 1 * 32 + h])), g2 = sigmoidf_(bf2f(proj[rowq + NSA_GL + 2 * 32 + h]));
    f32x16 o[4];
#pragma unroll
    for (int d = 0; d < 4; ++d) { o[d] = f32x16{}; }
    __syncthreads();

    {
      const bf16* kc = KC + (size_t)(b * 4 + g) * 128 * 128; const bf16* vc = VC + (size_t)(b * 4 + g) * 128 * 128;
      { const bf16* kcp = kc + krow * 128 + kcol; const bf16* vcp = vc + vrow * 128 + vcol; TDMA(kcp, vcp, 128, 0, 0); TDMA(kcp + 64 * 128, vcp + 64 * 128, 128, 1, 1); }
      TWAIT();
      f32x16 pA0, pA1, pB0, pB1;
      qkt(pA0, pA1, K_lds, qr, r32, hi); qkt(pB0, pB1, K_lds + SHM_K, qr, r32, hi);
      __syncthreads();
      if (VAR < 5) TDMA(proj + (size_t)(b * SEQ + cur * 64 + krow) * NSA_NP + NSA_KS + g * 128 + kcol, proj + (size_t)(b * SEQ + cur * 64 + vrow) * NSA_NP + NSA_VS + g * 128 + vcol, NSA_NP, 0, 2);
      const float sl16 = 16.f * slope2, s32_ = sl16 + sl16, s64_ = s32_ + s32_, s128_ = s64_ + s64_;
      const float baseA = slope2 * (float)(16 * (4 * hi) + 31 - t);
      const float ca_[4] = {0.f, sl16, s32_, s32_ + sl16};
      float cb_[16]; cb_[0] = baseA;
#pragma unroll
      for (int q = 1; q < 16; ++q) cb_[q] = cb_[q - 1] + s128_;
      float mx = -1e30f;
      const int nlim = ((t - 31) >> 4) - 4 * hi;
#pragma unroll
      for (int r = 0; r < 16; ++r) { const int c = (r & 3) + 8 * (r >> 2);
        float a0 = fmaf(pA0[r], CSC, ca_[r & 3] + cb_[r >> 2]), a1 = fmaf(pA1[r], CSC, ca_[r & 3] + cb_[4 + (r >> 2)]);
        float b0 = fmaf(pB0[r], CSC, ca_[r & 3] + cb_[8 + (r >> 2)]), b1 = fmaf(pB1[r], CSC, ca_[r & 3] + cb_[12 + (r >> 2)]);
        a0 = (c > nlim) ? -1e30f : a0; a1 = (c + 32 > nlim) ? -1e30f : a1;
        b0 = (c + 64 > nlim) ? -1e30f : b0; b1 = (c + 96 > nlim || (c == 27 && hi)) ? -1e30f : b1;
        pA0[r] = a0; pA1[r] = a1; pB0[r] = b0; pB1[r] = b1; mx = fmaxf(fmaxf(mx, fmaxf(a0, a1)), fmaxf(b0, b1)); }
      mx = swapmax(mx);
      float ps = 0.f;
#pragma unroll
      for (int r = 0; r < 16; ++r) { pA0[r] = __builtin_amdgcn_exp2f(pA0[r] - mx); pA1[r] = __builtin_amdgcn_exp2f(pA1[r] - mx); pB0[r] = __builtin_amdgcn_exp2f(pB0[r] - mx); pB1[r] = __builtin_amdgcn_exp2f(pB1[r] - mx);
        ps += (pA0[r] + pA1[r]) + (pB0[r] + pB1[r]); }
      ps = swapsum(ps);
      const float anyv = (t >= 31) ? 1.f : 0.f; const float inv = anyv / ps;
      bf16x8 pa0, pa1, pa2, pa3;
      bf16x8 pa4, pa5, pa6, pa7;
      PK4(pA0, 0, pa0); PK4(pA0, 8, pa1); PK4(pA1, 0, pa2); PK4(pA1, 8, pa3);
      PK4(pB0, 0, pa4); PK4(pB0, 8, pa5); PK4(pB1, 0, pa6); PK4(pB1, 8, pa7);
      SBAR();
      if (cur <= 15) {
        if (lane == 0) { mkl[4 * wid + 0] = 0xffffffffu; mkl[4 * wid + 1] = 0xffffffffu; mkl[4 * wid + 2] = 0xffffffffu; mkl[4 * wid + 3] = 0xffffffffu; }
      } else {
#pragma unroll
      for (int r = 0; r < 16; ++r) {
        float a0 = pA0[r] * inv, a1 = pA1[r] * inv, b0 = pB0[r] * inv, b1 = pB1[r] * inv;
        a0 += dppx<0xB1>(a0); a1 += dppx<0xB1>(a1); b0 += dppx<0xB1>(b0); b1 += dppx<0xB1>(b1);
        a0 += dppx<0x4E>(a0); a1 += dppx<0x4E>(a1); b0 += dppx<0x4E>(b0); b1 += dppx<0x4E>(b1);
        a0 += dppx<0x141>(a0); a1 += dppx<0x141>(a1); b0 += dppx<0x141>(b0); b1 += dppx<0x141>(b1);
        pA0[r] = a0; pA1[r] = a1; pB0[r] = b0; pB1[r] = b1; }
      float slc[16];
#pragma unroll
      for (int T = 0; T < 4; ++T)
#pragma unroll
        for (int q = 0; q < 4; ++q) {
          const f32x16& P = (T == 0) ? pA0 : (T == 1) ? pA1 : (T == 2) ? pB0 : pB1;
          slc[T * 4 + q] = 2.f * (P[4 * q] + P[4 * q + 1] + P[4 * q + 2]) + P[4 * q + 3];
          float a;
          if (q > 0) a = P[4 * (q - 1) + 3];
          else if (T > 0) { const f32x16& Pm = (T == 1) ? pA0 : (T == 2) ? pA1 : pB0; a = Pm[15]; }
          else a = 0.f;
          const float give = hi ? a : P[4 * q + 3];
          { auto rr_ = __builtin_amdgcn_permlane32_swap(__float_as_uint(give), __float_as_uint(give), false, false); slc[T * 4 + q] += __uint_as_float(hi ? rr_[0] : rr_[1]); } }
      if (j == 0) {
#pragma unroll
        for (int T = 0; T < 4; ++T)
#pragma unroll
          for (int q = 0; q < 4; ++q) { const int blk = 8 * T + 2 * q + hi;
            const float s = (blk == 0 || blk == cur || blk == cur - 1) ? 1e6f : (blk > cur ? -1.0f : slc[T * 4 + q]);
            scl[(4 * wid + tsub) * 32 + blk] = s; }
      }
      asm volatile("s_waitcnt lgkmcnt(0)" ::: "memory");
#pragma unroll
      for (int pss = 0; pss < 2; ++pss) {
        const int tl = 4 * wid + 2 * pss + hi, blk = r32; const float* row = scl + tl * 32; const float mys = row[blk]; int rank = 0;
#pragma unroll
        for (int q4 = 0; q4 < 8; ++q4) { const v4f v = *(const v4f*)(row + 4 * q4);
          rank += (v.x > mys || (v.x == mys && 4 * q4 + 0 < blk)) ? 1 : 0; rank += (v.y > mys || (v.y == mys && 4 * q4 + 1 < blk)) ? 1 : 0;
          rank += (v.z > mys || (v.z == mys && 4 * q4 + 2 < blk)) ? 1 : 0; rank += (v.w > mys || (v.w == mys && 4 * q4 + 3 < blk)) ? 1 : 0; }
        const unsigned long long bal = __ballot(rank < 16);
        if (lane == 0) { mkl[4 * wid + 2 * pss] = (unsigned)bal; mkl[4 * wid + 2 * pss + 1] = (unsigned)(bal >> 32); }
      }
      }
      SBAR();
      pv_d0(o, vb0, pa0, pa1, pa2, pa3);
      pv_d0(o, vb0 + SHM_V, pa4, pa5, pa6, pa7);
      SBAR();
      FOLD(g0 * inv, true);
    }
    __syncthreads();
    unsigned anymask = 0u;
#pragma unroll
    for (int i = 0; i < 32; ++i) anymask |= mkl[i];
    anymask = __builtin_amdgcn_readfirstlane(anymask);
    const unsigned mymask = mkl[4 * wid + tsub];

    int it = 0, vbuf = 2;
#pragma unroll
    for (int br = 0; br < 2; ++br) {
      const bf16* Kg = proj + (size_t)(b * SEQ) * NSA_NP + (br == 0 ? NSA_KS : NSA_KW) + g * 128;
      const bf16* Vg = proj + (size_t)(b * SEQ) * NSA_NP + (br == 0 ? NSA_VS : NSA_VW) + g * 128;
      const int wlo = t0 + 31 - 511;
      const int kb_lo = (br == 0) ? 0 : ((t0 - 511 > 0 ? t0 - 511 : 0) >> 6);
      unsigned tiles = (br == 0) ? (anymask & (cur == 31 ? 0xffffffffu : ((2u << cur) - 1u))) : ((cur == 31 ? 0xffffffffu : ((2u << cur) - 1u)) & ~((1u << kb_lo) - 1u));
      const int tlo = (br == 0) ? 0 : (t - 511 > 0 ? t - 511 : 0);
      float m = -1e30f, l = 0.f;
#pragma unroll
      for (int d = 0; d < 4; ++d) o[d] = f32x16{};
      const bf16* kgp = Kg + (size_t)krow * NSA_NP + kcol; const bf16* vgp = Vg + (size_t)vrow * NSA_NP + vcol;
      int kb = 31 - __builtin_clz(tiles); tiles &= ~(1u << kb);
#define TILE_SM(KB, PA0, PA1, PA2, PA3, AL) do { const int kp0_ = (KB) * 64 + 4 * hi; const float rowbias_ = (br == 0 && !((mymask >> (KB)) & 1u)) ? -1e30f : 0.f; \
        const bool need_mask_ = ((KB) == cur) || (br == 1 && (KB) * 64 < wlo); \
        if (VAR == 1 || VAR == 2) { AL = 1.f; l += rowbias_ + (need_mask_ ? 1.f : 2.f); _Pragma("unroll") for (int r = 0; r < 16; ++r) { p0[r] = __builtin_fmaxf(p0[r], -3.0e38f); p1[r] = __builtin_fmaxf(p1[r], -3.0e38f); } \
          PK4(p0, 0, PA0); PK4(p0, 8, PA1); PK4(p1, 0, PA2); PK4(p1, 8, PA3); } else { \
        score_xform(p0, p1, slope2, slope2 * (float)(kp0_ - t) + rowbias_, need_mask_, kp0_, t, tlo); \
        softmax_step(p0, p1, m, l, AL, PA0, PA1, PA2, PA3); } } while (0)
      if (VAR < 5) for (;;) {
        const int kbuf = it & 1;
        TWAIT();
        const int kbn = tiles ? 31 - __builtin_clz(tiles) : -1; const int vbn = (vbuf == 2) ? 0 : vbuf + 1;
        if (kbn >= 0) { tiles &= ~(1u << kbn); TDMA(kgp + (size_t)kbn * 64 * NSA_NP, vgp + (size_t)kbn * 64 * NSA_NP, NSA_NP, kbuf ^ 1, vbn); }
        else if (br == 0) TDMA(kgp + (size_t)cur * 64 * NSA_NP + (NSA_KW - NSA_KS), vgp + (size_t)cur * 64 * NSA_NP + (NSA_VW - NSA_VS), NSA_NP, kbuf ^ 1, vbn);
        if (VAR != 4) { f32x16 p0, p1; if (VAR != 3) qkt(p0, p1, K_lds + kbuf * SHM_K, qr, r32, hi); else { p0 = o[0]; p1 = o[1]; }
          float alpha_; bf16x8 pa0_, pa1_, pa2_, pa3_; TILE_SM(kb, pa0_, pa1_, pa2_, pa3_, alpha_); RESC(alpha_);
          if (VAR != 2) pv_d0(o, vb0 + vbuf * SHM_V, pa0_, pa1_, pa2_, pa3_); else { o[0][0] += __builtin_bit_cast(float, pa0_[0] | (pa1_[1] << 16)) + __builtin_bit_cast(float, pa2_[0] | (pa3_[1] << 16)); } }
        if (kbn < 0) break;
        kb = kbn; ++it; vbuf = vbn;
      }
      ++it; vbuf = (vbuf == 2) ? 0 : vbuf + 1;
#undef TILE_SM
      if (br == 0) { FOLD(g1 / l, false); __syncthreads(); }
      else { __syncthreads(); FOLDL(g2 / l); }
    }

    if (VAR != 6) {
      v4u zv[8];
#pragma unroll
      for (int j = 0; j < 8; ++j) { const int row = 4 * j + (lane >> 4), tt = t0 + 4 * wid + (row >> 3), hh = g * 8 + (row & 7);
        zv[j] = *(const v4u*)(proj + (size_t)(b * SEQ + tt) * NSA_NP + NSA_Z + hh * 128 + (lane & 15) * 8); }
#pragma unroll
      for (int j = 0; j < 8; ++j) { const int row = 4 * j + (lane >> 4), tt = t0 + 4 * wid + (row >> 3), hh = g * 8 + (row & 7);
        const v4u tv = *(const v4u*)((const unsigned short*)(lds + AT_K) + (wid * 32 + row) * ROWP + (lane & 15) * 8); const v4u z = zv[j]; v4u y;
        y.x = cvtpk(bflo(tv.x) * siluf_(bflo(z.x)), bfhi(tv.x) * siluf_(bfhi(z.x))); y.y = cvtpk(bflo(tv.y) * siluf_(bflo(z.y)), bfhi(tv.y) * siluf_(bfhi(z.y)));
        y.z = cvtpk(bflo(tv.z) * siluf_(bflo(z.z)), bfhi(tv.z) * siluf_(bfhi(z.z))); y.w = cvtpk(bflo(tv.w) * siluf_(bflo(z.w)), bfhi(tv.w) * siluf_(bfhi(z.w)));
        *(v4u*)(Y + (size_t)(b * SEQ + tt) * DM + hh * 128 + (lane & 15) * 8) = y; }
    }
  }
  __syncthreads();
#undef TDMA
#undef TWAIT
#undef RESC
#undef FOLD
#undef FOLDL
}

__device__ __forceinline__ void rg_conv(Frame& F) {
    const bf16* proj = (const bf16*)FW(F, WS_PROJ); bf16* XC = (bf16*)FW(F, WS_Y);
    const float* conv_w = FIN(F, 9); const float* conv_b = FIN(F, 10);
    constexpr int CR = 16;
    for (int it = F.vcu * NTHREADS + F.tid; it < (MTOK / CR) * 512; it += F.G * NTHREADS) {
        const int row0 = (it >> 9) * CR, ch = (it & 511) * 8; const bool head = (row0 & (SEQ - 1)) == 0;
        v4u x[CR + 3];
#pragma unroll
        for (int i = 0; i < CR + 3; ++i) x[i] = *(const v4u*)(proj + (size_t)((i < 3 && head) ? row0 : row0 - 3 + i) * RG_NP + ch);
        v4f w0[4], w1[4];
#pragma unroll
        for (int k4 = 0; k4 < 4; ++k4) { w0[k4] = *(const v4f*)(conv_w + k4 * DM + ch); w1[k4] = *(const v4f*)(conv_w + k4 * DM + ch + 4); }
        const v4f b0 = *(const v4f*)(conv_b + ch), b1 = *(const v4f*)(conv_b + ch + 4);
#pragma unroll
        for (int i = 0; i < 3; ++i) { x[i].x = head ? 0u : x[i].x; x[i].y = head ? 0u : x[i].y; x[i].z = head ? 0u : x[i].z; x[i].w = head ? 0u : x[i].w; }
#pragma unroll
        for (int j = 0; j < CR; ++j) { v4f a0 = b0, a1 = b1;
#pragma unroll
            for (int k4 = 0; k4 < 4; ++k4) { const v4u xx = x[j + k4];
                a0.x += w0[k4].x * bflo(xx.x); a0.y += w0[k4].y * bfhi(xx.x); a0.z += w0[k4].z * bflo(xx.y); a0.w += w0[k4].w * bfhi(xx.y);
                a1.x += w1[k4].x * bflo(xx.z); a1.y += w1[k4].y * bfhi(xx.z); a1.z += w1[k4].z * bflo(xx.w); a1.w += w1[k4].w * bfhi(xx.w); }
            v4u o; o.x = pk2(a0.x, a0.y); o.y = pk2(a0.z, a0.w); o.z = pk2(a1.x, a1.y); o.w = pk2(a1.z, a1.w);
            *(v4u*)(XC + (size_t)(row0 + j) * DM + ch) = o; }
    }
}
struct EpiRG {
    static constexpr bool PERM = false, AFTER_DRAIN = false;
    const bf16* XC; const float* gate_b; const float* SP; unsigned* AU;
    __device__ __forceinline__ void operator()(const pg8::f32x4 (&acc)[2][2][4][2], const pg8::Unit& u, int wr, int wc, int fr, int fq) const {
        asm volatile("" : "+v"(fr), "+v"(fq));
        const int row0 = u.pm * 256 + wr * 64 + fr, ch0 = u.pn * 128 + wc * 32 + 4 * fq;
        v4f biv[2], brv[2], spv[2];
        v2u xv[2][2][4];
#pragma unroll
        for (int n = 0; n < 2; ++n)
#pragma unroll
            for (int ai = 0; ai < 2; ++ai)
#pragma unroll
                for (int m = 0; m < 4; ++m) xv[n][ai][m] = *(const v2u*)(XC + (size_t)(row0 + ai * 128 + m * 16) * DM + ch0 + 16 * n);
#pragma unroll
        for (int n = 0; n < 2; ++n) { biv[n] = *(const v4f*)(gate_b + ch0 + 16 * n); brv[n] = *(const v4f*)(gate_b + DM + ch0 + 16 * n); spv[n] = *(const v4f*)(SP + ch0 + 16 * n); }
#pragma unroll
        for (int n = 0; n < 2; ++n) { const int ch = ch0 + 16 * n; const v4f bi = biv[n], br = brv[n], sp = spv[n];
#pragma unroll
            for (int ai = 0; ai < 2; ++ai)
#pragma unroll
                for (int m = 0; m < 4; ++m) { const int row = row0 + ai * 128 + m * 16; const bool first = (row & (SEQ - 1)) == 0; const size_t off = (size_t)row * DM + ch;
                    const v2u xw = xv[n][ai][m]; const float x[4] = {bflo(xw.x), bfhi(xw.x), bflo(xw.y), bfhi(xw.y)};
                    const pg8::f32x4 vi = acc[ai][0][m][n], vr = acc[ai][1][m][n]; v4u av;
#pragma unroll
                    for (int j = 0; j < 4; ++j) { const float ig = sigmoidf_(vi[j] + bi[j]), rg = sigmoidf_(vr[j] + br[j]);
                        const float la = -8.0f * rg * sp[j];
                        const float oma = 1.0f - __expf(la);
                        const float mult = first ? 1.0f : __builtin_amdgcn_sqrtf(oma * (2.0f - oma));
                        av[j] = pg8::cvt_pk_bf16(oma, mult * ig * x[j]); }
                    *(v4u*)(AU + off) = av;
                    if (m & 1) asm volatile("" ::: "memory"); } }
    }
};

constexpr int HG_Q = 0, HG_K = 16384, HG_V = 32768, HG_KH = 49152  , HG_S = 67584  , HG_O = 100352  , HG_DEC = 117760, HG_CS = 118272  , HG_GN = 122368  ;

__device__ __forceinline__ void hg_qkt1(at::f32x16& p, const char* Ks, int rowbase, const at::bf16x8* qr, int r32, int hi) {
  p = at::f32x16{};
  at::bf16x8 kf[8];
#pragma unroll
  for (int d0 = 0; d0 < 8; ++d0) kf[d0] = *reinterpret_cast<const at::bf16x8*>(Ks + KSWZ(rowbase + r32, (d0 * 16 + hi * 8) * 2));
#pragma unroll
  for (int d0 = 0; d0 < 8; ++d0) p = __builtin_amdgcn_mfma_f32_32x32x16_bf16(kf[d0], qr[d0], p, 0, 0, 0);
}
__device__ __forceinline__ void hg_pv_half(at::f32x16& od, int vb, at::bf16x8 pa0, at::bf16x8 pa1) {
  using namespace at;
  const s16x4 l0 = tr_read<v_rd_off(0, 0, 0)>(vb), h0 = tr_read<v_rd_off(0, 0, 1)>(vb), l1 = tr_read<v_rd_off(0, 1, 0)>(vb), h1 = tr_read<v_rd_off(0, 1, 1)>(vb);
  asm volatile("s_waitcnt lgkmcnt(0)" ::: "memory"); SBAR();
#define PK(L, H) (bf16x8){L[0], L[1], L[2], L[3], H[0], H[1], H[2], H[3]}
  od = __builtin_amdgcn_mfma_f32_32x32x16_bf16(pa0, PK(l0, h0), od, 0, 0, 0);
  od = __builtin_amdgcn_mfma_f32_32x32x16_bf16(pa1, PK(l1, h1), od, 0, 0, 0);
#undef PK
}

__device__ __forceinline__ void hg_mfma(Frame& F, bf16* Y, int u, unsigned* prog = nullptr) {
  using namespace at;
  const bf16* proj = (const bf16*)FW(F, WS_PROJ);
  const float* LB = (const float*)FW(F, WS_MISC + MISC_LB);
  unsigned char* lds = F.lds;
  const int wid = F.wave;
  {
    int lane = F.lane; asm volatile("" : "+v"(lane));
    const int tid = wid * 64 + lane, r32 = lane & 31, hi = lane >> 5;
    const int b = u >> 5, hd = u & 31;
    const int dp = lane, te = wid;
    const int sr = tid >> 4, sc = (tid & 15) * 8;
    const int tb = wid & 1, vb = wid >> 1;
    const int dblk = wid >> 1, vblk0 = 2 * (wid & 1);
    const int vbV = (int)(uintptr_t)((LAS unsigned char*)lds + HG_V) + v_rd_base(lane);
    const int vbS = (int)(uintptr_t)((LAS unsigned char*)lds + HG_S) + v_rd_base(lane);
    const float lb0 = LB[hd * 128 + 2 * dp], lb1 = LB[hd * 128 + 2 * dp + 1];
    const size_t row0 = (size_t)b * SEQ;
    f32x16 Sa = f32x16{}, Sb = f32x16{};
    v4u ga, gb;
    __syncthreads();
    for (int i = tid; i < 32768 / 16; i += NTHREADS) { v4u z; z.x = 0u; z.y = 0u; z.z = 0u; z.w = 0u; *(v4u*)(lds + HG_S + i * 16) = z; }
    if (tid < 128) ((float*)(lds + HG_GN))[tid] = FIN(F, 17)[tid];
    unsigned qraw[8], fraw[8]; v4u vs0, vs1;
#define HG_LOAD(c) do { const size_t rr_ = row0 + (size_t)(c) * 64; \
      _Pragma("unroll") for (int i = 0; i < 8; ++i) { const size_t o_ = (rr_ + 8 * te + i) * HG_NP + hd * 128 + 2 * dp; qraw[i] = *(const unsigned*)(proj + o_); fraw[i] = *(const unsigned*)(proj + o_ + 4096); } \
      vs0 = *(const v4u*)(proj + (rr_ + sr) * HG_NP + 8192 + hd * 128 + sc); vs1 = *(const v4u*)(proj + (rr_ + 32 + sr) * HG_NP + 8192 + hd * 128 + sc); } while (0)
    HG_LOAD(0);
    for (int c = 0; c < SEQ / 64; ++c) {
      float q0[8], q1[8], k0[8], k1[8], c0[8], c1[8];
      { float a0 = 0.f, a1 = 0.f;
#pragma unroll
        for (int i = 0; i < 8; ++i) { const float f0 = lb0 + (1.f - lb0) * sigmoidf_(bflo(fraw[i])), f1 = lb1 + (1.f - lb1) * sigmoidf_(bfhi(fraw[i]));
          q0[i] = siluf_(bflo(qraw[i])); q1[i] = siluf_(bfhi(qraw[i])); k0[i] = 1.f - f0; k1[i] = 1.f - f1;
          a0 += __logf(f0); a1 += __logf(f1); c0[i] = a0; c1[i] = a1; } }
      { float* cs = (float*)(lds + HG_CS); cs[te * 128 + 2 * dp] = c0[7]; cs[te * 128 + 2 * dp + 1] = c1[7]; }
      *(v4u*)(lds + HG_V + v_st(sr, sc)) = vs0; *(v4u*)(lds + HG_V + v_st(32 + sr, sc)) = vs1;
      __syncthreads();
      { const float* cs = (const float*)(lds + HG_CS); float off0 = 0.f, off1 = 0.f, tot0 = 0.f, tot1 = 0.f;
#pragma unroll
        for (int s = 0; s < 8; ++s) { const v2f x = *(const v2f*)(cs + s * 128 + 2 * dp); tot0 += x.x; tot1 += x.y; if (s < te) { off0 += x.x; off1 += x.y; } }
        unsigned kh0[4], kh1[4]; const float et0 = __expf(tot0), et1 = __expf(tot1);
#pragma unroll
        for (int i = 0; i < 8; ++i) { const float b0 = off0 + c0[i], b1 = off1 + c1[i]; const int t = 8 * te + i;
          const float e0 = __expf(b0), e1 = __expf(b1), r0 = __builtin_amdgcn_rcpf(e0), r1 = __builtin_amdgcn_rcpf(e1);
          *(unsigned*)(lds + HG_Q + KSWZ(t, 4 * dp)) = at::cvtpk(q0[i] * e0, q1[i] * e1);
          const float kt0 = k0[i] * r0, kt1 = k1[i] * r1;
          *(unsigned*)(lds + HG_K + KSWZ(t, 4 * dp)) = at::cvtpk(kt0, kt1);
          const float h0 = kt0 * et0, h1 = kt1 * et1;
          if (i & 1) { kh0[i >> 1] |= f2bf(h0) << 16; kh1[i >> 1] |= f2bf(h1) << 16; } else { kh0[i >> 1] = f2bf(h0); kh1[i >> 1] = f2bf(h1); } }
        { v4u w; w.x = kh0[0]; w.y = kh0[1]; w.z = kh0[2]; w.w = kh0[3]; *(v4u*)(lds + HG_KH + (2 * dp) * 144 + te * 16) = w;
          w.x = kh1[0]; w.y = kh1[1]; w.z = kh1[2]; w.w = kh1[3]; *(v4u*)(lds + HG_KH + (2 * dp + 1) * 144 + te * 16) = w; }
        if (te == 0) { float* dec = (float*)(lds + HG_DEC); dec[2 * dp] = et0; dec[2 * dp + 1] = et1; } }
      if (c + 1 < SEQ / 64) HG_LOAD(c + 1);
      __syncthreads();
      { const size_t row_ = row0 + (size_t)c * 64 + (tid >> 3); ga = *(const v4u*)(proj + row_ * HG_NP + 12288 + hd * 128 + (tid & 7) * 16); gb = *(const v4u*)(proj + row_ * HG_NP + 12288 + hd * 128 + (tid & 7) * 16 + 8); }
      {
        bf16x8 qr[8];
#pragma unroll
        for (int d0 = 0; d0 < 8; ++d0) qr[d0] = *reinterpret_cast<const bf16x8*>((const char*)lds + HG_Q + KSWZ(32 * tb + r32, (d0 * 16 + hi * 8) * 2));
        f32x16 o = f32x16{};
        {
          f32x16 pd; hg_qkt1(pd, (const char*)lds + HG_K, 32 * tb, qr, r32, hi);
#pragma unroll
          for (int r = 0; r < 16; ++r) { const int cr = (r & 3) + 8 * (r >> 2) + 4 * hi; pd[r] = (cr > r32) ? 0.f : pd[r]; }
          bf16x8 pa0, pa1, pa2, pa3;
          if (tb == 0) { PK4(pd, 0, pa0); PK4(pd, 8, pa1); hg_pv_half(o, vbV + vb * 512, pa0, pa1); }
          else { f32x16 pf; hg_qkt1(pf, (const char*)lds + HG_K, 0, qr, r32, hi);
#pragma unroll
            for (int r = 0; r < 16; ++r) pf[r] = __builtin_fmaxf(pf[r], -3.0e38f);
            PK4(pf, 0, pa0); PK4(pf, 8, pa1); PK4(pd, 0, pa2); PK4(pd, 8, pa3); pv_one<0>(o, vbV + vb * 512, pa0, pa1, pa2, pa3); }
        }
        pv_one<0>(o, vbS + vb * 512, qr[0], qr[1], qr[2], qr[3]);
        pv_one<0>(o, vbS + 16384 + vb * 512, qr[4], qr[5], qr[6], qr[7]);
#pragma unroll
        for (int r = 0; r < 16; ++r) { const int t = 32 * tb + crow(r, hi); *(bf16*)(lds + HG_O + t * 272 + (32 * vb + r32) * 2) = (bf16)f2bf(o[r]); }
        { const float* dec = (const float*)(lds + HG_DEC);
#pragma unroll
          for (int r = 0; r < 16; ++r) { const float dv = dec[32 * dblk + crow(r, hi)]; Sa[r] *= dv; Sb[r] *= dv; }
          bf16x8 kh[4];
#pragma unroll
          for (int ks = 0; ks < 4; ++ks) kh[ks] = *reinterpret_cast<const bf16x8*>((const char*)lds + HG_KH + (32 * dblk + r32) * 144 + (16 * ks + 8 * hi) * 2);
          pv_one<0>(Sa, vbV + vblk0 * 512, kh[0], kh[1], kh[2], kh[3]);
          pv_one<0>(Sb, vbV + (vblk0 + 1) * 512, kh[0], kh[1], kh[2], kh[3]); }
      }
      const bool post = prog && (c & 3) == 0 && c > 0 && c <= 16;
      if (post) asm volatile("s_waitcnt vmcnt(0)" ::: "memory");
      __syncthreads();
      if (post && tid == 0) { __builtin_amdgcn_fence(__ATOMIC_RELEASE, "agent"); asm volatile("s_waitcnt vmcnt(0)" ::: "memory"); (void)xb_add(prog + b * 8 + (c >> 2) - 1, 1u); }
#pragma unroll
      for (int r = 0; r < 16; ++r) { const int d = 32 * dblk + crow(r, hi);
        *(bf16*)(lds + HG_S + (d >> 6) * 16384 + v_st(d & 63, 32 * vblk0 + r32)) = (bf16)f2bf(Sa[r]);
        *(bf16*)(lds + HG_S + (d >> 6) * 16384 + v_st(d & 63, 32 * (vblk0 + 1) + r32)) = (bf16)f2bf(Sb[r]); }
      { const int t = tid >> 3, seg = tid & 7; const size_t row = row0 + (size_t)c * 64 + t;
        const v4u oa = *(const v4u*)(lds + HG_O + t * 272 + seg * 32), ob = *(const v4u*)(lds + HG_O + t * 272 + seg * 32 + 16);
        const unsigned ow[8] = {oa.x, oa.y, oa.z, oa.w, ob.x, ob.y, ob.z, ob.w}, gw[8] = {ga.x, ga.y, ga.z, ga.w, gb.x, gb.y, gb.z, gb.w};
        float ss = 0.f;
#pragma unroll
        for (int i = 0; i < 8; ++i) { const float a = bflo(ow[i]), bq = bfhi(ow[i]); ss += a * a + bq * bq; }
        ss += at::dppx<0xB1>(ss); ss += at::dppx<0x4E>(ss); ss += at::dppx<0x141>(ss);
        const float rstd = rsqrtf(ss * (1.f / 128.f) + NORM_EPS);
        unsigned yw[8]; const float* gnl = (const float*)(lds + HG_GN) + seg * 16;
#pragma unroll
        for (int i = 0; i < 8; ++i) { const v2f g2 = *(const v2f*)(gnl + 2 * i); const float gx = g2.x, gy = g2.y;
          yw[i] = at::cvtpk(bflo(ow[i]) * rstd * gx * siluf_(bflo(gw[i])), bfhi(ow[i]) * rstd * gy * siluf_(bfhi(gw[i]))); }
        v4u y0, y1; y0.x = yw[0]; y0.y = yw[1]; y0.z = yw[2]; y0.w = yw[3]; y1.x = yw[4]; y1.y = yw[5]; y1.z = yw[6]; y1.w = yw[7];
        *(v4u*)(Y + row * DM + hd * 128 + seg * 16) = y0; *(v4u*)(Y + row * DM + hd * 128 + seg * 16 + 8) = y1; }
    }
#undef HG_LOAD
  }
  __syncthreads();
}

constexpr size_t MISC_W1T = 4 * MiB;
constexpr size_t MISC_W2T = 8 * MiB;
__device__ __forceinline__ unsigned pk2n(float lo, float hi) { unsigned r; asm("v_cvt_pk_bf16_f32 %0, %1, %2" : "=v"(r) : "v"(lo), "v"(hi)); return r; }
__device__ __forceinline__ void nsa_compress_mfma(Frame& F, int j) {
    typedef short bf16x8 __attribute__((ext_vector_type(8)));
    typedef float f32x4 __attribute__((ext_vector_type(4)));
    const bf16* proj = (const bf16*)FW(F, WS_PROJ);
    float* red = (float*)(F.lds);
    bf16* hid = (bf16*)(F.lds + 65536);
    const int wid = F.wave;
    for (int u = F.vcu; u < 256; u += F.G) {
        int lane = F.lane; asm volatile("" : "+v"(lane));
        const int tid = wid * 64 + lane, r16 = lane & 15, kq = lane >> 4;
        const int which = u >> 7, T = u & 127, b = T >> 5, n0 = 4 * (T & 31);
        const int n = n0 + (r16 >> 2), g = r16 & 3; const bool valid = n < 127;
        const bf16* W1T = (const bf16*)FW(F, WS_MISC + MISC_W1T) + (size_t)(j * 2 + which) * 128 * 4096;
        const bf16* W2T = (const bf16*)FW(F, WS_MISC + MISC_W2T) + (size_t)(j * 2 + which) * 128 * 128;
        const float* pe = FIN(F, 4) + (size_t)(j * 2 + which) * 32 * 128;
        const int col0 = which ? NSA_VC : NSA_KC;
        bf16* dst = (bf16*)FW(F, WS_SCR) + (size_t)which * (BATCH * 4 * 128 * 128);
        f32x4 acc[8];
#pragma unroll
        for (int ct = 0; ct < 8; ++ct) acc[ct] = (f32x4){0.f, 0.f, 0.f, 0.f};
        __syncthreads();
        const bf16* xrow = proj + (size_t)(b * SEQ + 16 * (valid ? n : 126)) * NSA_NP + col0 + g * 128 + 8 * kq;
        const bf16* wrow = W1T + (size_t)r16 * 4096 + 8 * kq; const float* perow = pe + 8 * kq;
        v4u xb[3]; v4f pb[3][2]; bf16x8 wb[3][8];
#define CMP_LOAD(S_, SL_) do { const int l_ = 4 * wid + ((S_) >> 2), d_ = 32 * ((S_) & 3); \
            xb[SL_] = *(const v4u*)(xrow + (size_t)l_ * NSA_NP + d_); pb[SL_][0] = *(const v4f*)(perow + l_ * 128 + d_); pb[SL_][1] = *(const v4f*)(perow + l_ * 128 + d_ + 4); \
            _Pragma("unroll") for (int ct = 0; ct < 8; ++ct) wb[SL_][ct] = *(const bf16x8*)(wrow + (size_t)(ct * 16) * 4096 + l_ * 128 + d_); } while (0)
        CMP_LOAD(0, 0); CMP_LOAD(1, 1);
#pragma unroll
        for (int s = 0; s < 16; ++s) {
            if (s + 2 < 16) CMP_LOAD(s + 2, (s + 2) % 3);
            __builtin_amdgcn_sched_barrier(0);
            const v4u x = xb[s % 3]; const v4f p0 = pb[s % 3][0], p1 = pb[s % 3][1];
            v4u aw; aw.x = pk2n(bflo(x.x) + p0.x, bfhi(x.x) + p0.y); aw.y = pk2n(bflo(x.y) + p0.z, bfhi(x.y) + p0.w);
            aw.z = pk2n(bflo(x.z) + p1.x, bfhi(x.z) + p1.y); aw.w = pk2n(bflo(x.w) + p1.z, bfhi(x.w) + p1.w);
            aw.x = valid ? aw.x : 0u; aw.y = valid ? aw.y : 0u; aw.z = valid ? aw.z : 0u; aw.w = valid ? aw.w : 0u;
            const bf16x8 af = __builtin_bit_cast(bf16x8, aw);
#pragma unroll
            for (int ct = 0; ct < 8; ++ct) acc[ct] = __builtin_amdgcn_mfma_f32_16x16x32_bf16(af, wb[s % 3][ct], acc[ct], 0, 0, 0);
            __builtin_amdgcn_sched_barrier(0);
        }
#undef CMP_LOAD
#pragma unroll
        for (int ct = 0; ct < 8; ++ct)
#pragma unroll
            for (int q = 0; q < 4; ++q) red[(wid * 16 + kq * 4 + q) * 128 + ct * 16 + r16] = acc[ct][q];
        __syncthreads();
        { const int idx = tid * 4, row = idx >> 7, col = idx & 127; v4f sacc = *(const v4f*)(red + row * 128 + col);
#pragma unroll
          for (int w = 1; w < 8; ++w) { const v4f x = *(const v4f*)(red + (w * 16 + row) * 128 + col); sacc.x += x.x; sacc.y += x.y; sacc.z += x.z; sacc.w += x.w; }
          v2u o; o.x = pk2(gelu_tanh(sacc.x), gelu_tanh(sacc.y)); o.y = pk2(gelu_tanh(sacc.z), gelu_tanh(sacc.w));
          *(v2u*)(hid + row * 136 + col) = o; }
        __syncthreads();
        { f32x4 a2 = (f32x4){0.f, 0.f, 0.f, 0.f};
#pragma unroll
          for (int s = 0; s < 4; ++s) { const bf16x8 af = *(const bf16x8*)(hid + r16 * 136 + 32 * s + 8 * kq);
              const bf16x8 bfr = *(const bf16x8*)(W2T + (size_t)(wid * 16 + r16) * 128 + 32 * s + 8 * kq);
              a2 = __builtin_amdgcn_mfma_f32_16x16x32_bf16(af, bfr, a2, 0, 0, 0); }
#pragma unroll
          for (int q = 0; q < 4; ++q) { const int row = kq * 4 + q, nn = n0 + (row >> 2), gg = row & 3;
              dst[((size_t)(b * 4 + gg) * 128 + nn) * 128 + wid * 16 + r16] = (nn < 127) ? (bf16)f2bf(a2[q]) : (bf16)0; } }
    }
    __syncthreads();
}

#ifndef MK_ONE_LAUNCH
#define MK_ONE_LAUNCH 1
#endif
constexpr int NPHASE = 21;
static_assert((CW_BAR + XCD_BAR_WORDS) * 4 <= (int)CTL_ZERO_BYTES, "the per-call memset covers the grid-barrier words");
struct Args { const float* in[19]; float* out; unsigned char* ws; int ph_lo, ph_hi, li, pad; };

#define GEMM_BF16(Aptr, Bptr, N_, Optr, ldc_) do { \
        pg8::Gemm g_{(const pg8::bf16_t*)(Aptr), (const pg8::bf16_t*)(Bptr), MTOK, (N_), DM, DM, 0}; pg8::StaticOrder S_; S_.init(MTOK, (N_), F.G, (int)blockIdx.x); \
        pg8::EpiBf16<0> E_{(pg8::bf16_t*)(Optr), (ldc_), nullptr, 0, 0, 1.f}; \
        pg8::gemm_phase<pg8::EpiBf16<0>, pg8::StaticOrder, true, true>((PG8_LAS unsigned char*)lds + RING_OFF, g_, S_, E_); } while (0)

#define GEMM_IN(Bptr, N_) do { \
        pg8::Gemm g_{(const pg8::bf16_t*)FW(F, WS_H), (const pg8::bf16_t*)(Bptr), MTOK, (N_), DM, DM, 0}; pg8::StaticOrder S_; S_.init(MTOK, (N_), F.G, (int)blockIdx.x); \
        pg8::EpiBf16RS E_{(pg8::bf16_t*)FW(F, WS_PROJ), (N_), (const float*)FW(F, WS_MISC + MISC_RS)}; \
        pg8::gemm_phase<pg8::EpiBf16RS, pg8::StaticOrder, true, true>((PG8_LAS unsigned char*)lds + RING_OFF, g_, S_, E_); } while (0)

constexpr int CW_HGF = 128, CW_WOF = 192;
struct SchedEarly {
    int j; unsigned* hgf; unsigned* wof; unsigned* bar;
    __device__ __forceinline__ bool next(int i, pg8::Unit& u) const { if (i >= 2) return false; u.pm = 8 * (j >> 5) + 2 * i + ((j >> 4) & 1); u.pn = j & 15; return true; }
    __device__ __forceinline__ void a_ready(const pg8::Unit& u) const {
        XB_SPIN(xb_ld(wof) < 128u, bar); XB_SPIN(xb_ld(hgf + (u.pm >> 3) * 8 + (u.pm & 7)) < 32u, bar);
        __builtin_amdgcn_fence(__ATOMIC_ACQUIRE, "agent"); asm volatile("s_waitcnt vmcnt(0)" ::: "memory"); }
    __device__ __forceinline__ void done(const pg8::Unit&) const {}
};
struct SchedLate {
    int c;
    __device__ __forceinline__ bool next(int i, pg8::Unit& u) const { if (i >= 1) return false; const int x = c & 7, l = c >> 3; u.pm = 8 * (x >> 1) + 4 + (l & 3); u.pn = 8 * (x & 1) + (l >> 2); return true; }
    __device__ __forceinline__ void a_ready(const pg8::Unit&) const {}
    __device__ __forceinline__ void done(const pg8::Unit&) const {}
};
#define GEMM_WOUT_SCHED(SCHED, S_init) do { \
        pg8::Gemm g_{(const pg8::bf16_t*)FW(F, WS_Y), (const pg8::bf16_t*)FW(F, WS_W_HG_OUT), MTOK, DM, DM, DM, 0}; SCHED S_ S_init; \
        pg8::EpiBf16<0> E_{(pg8::bf16_t*)FW(F, WS_YO), DM, nullptr, 0, 0, 1.f}; \
        pg8::gemm_phase<pg8::EpiBf16<0>, SCHED, true, true>((PG8_LAS unsigned char*)lds + RING_OFF, g_, S_, E_); } while (0)

constexpr int CW_PF = 224;
struct SchedP {
    int e; unsigned* pf; unsigned* bar;
    __device__ __forceinline__ bool next(int i, pg8::Unit& u) const { if (i >= 2) return false; u.pm = e >> 2; u.pn = 4 * i + (e & 3); return true; }
    __device__ __forceinline__ void a_ready(const pg8::Unit& u) const { XB_SPIN(xb_ld(pf + (u.pn >> 2)) < 128u, bar); __builtin_amdgcn_fence(__ATOMIC_ACQUIRE, "agent"); asm volatile("s_waitcnt vmcnt(0)" ::: "memory"); }
    __device__ __forceinline__ void done(const pg8::Unit&) const {}
};
#define GEMM_IN2(Bptr, N_, Optr, ldc_) do { \
        pg8::Gemm g_{(const pg8::bf16_t*)FW(F, WS_H), (const pg8::bf16_t*)(Bptr), MTOK, (N_), DM, DM, 0}; pg8::StaticOrder S_; S_.init(MTOK, (N_), F.G, (int)blockIdx.x); \
        pg8::EpiBf16RS E_{(pg8::bf16_t*)(Optr), (ldc_), (const float*)FW(F, WS_MISC + MISC_RS)}; \
        pg8::gemm_phase<pg8::EpiBf16RS, pg8::StaticOrder, true, true>((PG8_LAS unsigned char*)lds + RING_OFF, g_, S_, E_); } while (0)

__device__ __forceinline__ bool phase_begin(Frame& F) { asm volatile("" : "+v"(F.tid)); asm volatile("" : "+s"(F.kin)); F.lane = F.tid & 63; return true; }

__global__ void __launch_bounds__(NTHREADS, 2) fwd_kernel(Args args) {
    extern __shared__ __attribute__((aligned(16))) unsigned char lds[];
    Frame F;
    F.lds = lds;
    F.tid = threadIdx.x; F.lane = F.tid & 63; F.wave = __builtin_amdgcn_readfirstlane(F.tid >> 6);
    F.G = gridDim.x; { const int bx = blockIdx.x; F.vcu = (F.G % 8 == 0) ? (bx % 8) * (F.G / 8) + bx / 8 : bx; }
    F.gw = F.vcu * NWAVES + F.wave; F.ngw = F.G * NWAVES;
    F.kin = (const float* const __attribute__((address_space(4)))*)__builtin_amdgcn_kernarg_segment_ptr();
    F.out = args.out; F.ws = args.ws;
    volatile LAS unsigned* MISC = (volatile LAS unsigned*)((LAS unsigned char*)lds + MISC_OFF);
    if (F.tid < 32) MISC[F.tid] = 0u;
    __syncthreads();
    const int lo = args.ph_lo, hi = args.ph_hi;
    unsigned* barw = (unsigned*)(F.ws + WS_CTL) + CW_BAR + args.li * XCD_BAR_WORDS;
    XcdBarrier bar; bar.bar = barw; bar.x = 0; bar.st = nullptr;
    if (hi - lo > 1) bar = xcd_barrier_post(barw, MISC + 8);
#define IN(k) (lo <= (k) && (k) < hi && phase_begin(F))
#define SEAM(k) do { if (lo <= (k) && (k) + 1 < hi) xcd_barrier(bar); } while (0)

    const bool p_split = (F.G == 256) && (lo <= 0 && 1 < hi);
    if (IN(0)) { p0_prologue(F, p_split); } SEAM(0);

    if (IN(1)) {
        if (p_split) { const int li = F.vcu & 31, xg = F.vcu >> 5; unsigned* ctl = (unsigned*)(F.ws + WS_CTL);
            if (li >= 16) p0_split_convert(F, xg * 16 + li - 16, 128, ctl + CW_PF);
            else { pg8::Gemm g_{(const pg8::bf16_t*)FW(F, WS_H), (const pg8::bf16_t*)FW(F, WS_W_NSA_IN), MTOK, NSA_NP, DM, DM, 0}; SchedP S_{xg * 16 + li, ctl + CW_PF, barw};
                pg8::EpiBf16RS E_{(pg8::bf16_t*)FW(F, WS_PROJ), NSA_NP, (const float*)FW(F, WS_MISC + MISC_RS)};
                pg8::gemm_phase<pg8::EpiBf16RS, SchedP, true, true>((PG8_LAS unsigned char*)lds + RING_OFF, g_, S_, E_);
                __syncthreads(); p0_split_tail(F, xg * 16 + li, 128); }
            xcd_barrier(bar);
            phase_begin(F);
            GEMM_IN2(FW(F, WS_W_NSA_IN + (size_t)2048 * DM * 2), NSA_NP - 2048, FW(F, WS_PROJ + (size_t)2048 * 2), NSA_NP); }
        else GEMM_IN(FW(F, WS_W_NSA_IN), NSA_NP);
        if (F.G == 256 && blockIdx.x >= 160) { __syncthreads(); p0_rg_in(F, (int)blockIdx.x - 160, 96); } } SEAM(1);
    if (IN(2)) { nsa_compress_mfma(F, 0); } SEAM(2);
    if (IN(3)) { nsa_attn_mfma<0>(F, (bf16*)FW(F, WS_Y)); } SEAM(3);
    if (IN(4)) { GEMM_BF16(FW(F, WS_Y), FW(F, WS_W_NSA_OUT), DM, FW(F, WS_YO), DM); } SEAM(4);
    if (IN(5)) { resid_phase(F, nullptr, (const bf16*)FW(F, WS_YO), FIN(F, 2) + 0 * DM, (bf16*)FW(F, WS_H), (float*)FW(F, WS_MISC + MISC_RS), nullptr); } SEAM(5);

    if (IN(6)) { GEMM_IN(FW(F, WS_W_RG_IN), RG_NP); } SEAM(6);
    if (IN(7)) { rg_conv(F); } SEAM(7);
    if (IN(8)) { int kk_ = 256; asm volatile("" : "+s"(kk_));
        pg8::Gemm g_{(const pg8::bf16_t*)FW(F, WS_Y), (const pg8::bf16_t*)FW(F, WS_MISC + MISC_GATE), MTOK, 8192, kk_, DM, 1}; pg8::StaticOrder S_; S_.init(MTOK, 8192, F.G, (int)blockIdx.x);
        EpiRG E_{(const bf16*)FW(F, WS_Y), FIN(F, 12), (const float*)FW(F, WS_MISC + MISC_SP), (unsigned*)FW(F, WS_SCR)};
        pg8::gemm_phase<EpiRG, pg8::StaticOrder, true, true>((PG8_LAS unsigned char*)lds + RING_OFF, g_, S_, E_); } SEAM(8);
    if (IN(9)) { rg_scan(F); } SEAM(9);
    if (IN(10)) { GEMM_BF16(FW(F, WS_Y), FW(F, WS_W_RG_OUT), DM, FW(F, WS_YO), DM); } SEAM(10);
    if (IN(11)) { resid_phase(F, nullptr, (const bf16*)FW(F, WS_YO), FIN(F, 2) + 1 * DM, (bf16*)FW(F, WS_H), (float*)FW(F, WS_MISC + MISC_RS), nullptr); } SEAM(11);

    if (IN(12)) { GEMM_IN(FW(F, WS_W_HG_IN), HG_NP); } SEAM(12);
    const bool hg_early = (F.G == 256) && (lo <= 13 && 14 < hi);
    if (IN(13)) {
        if (F.G == 256) { const int li = F.vcu & 31, xg = F.vcu >> 5; unsigned* ctl = (unsigned*)(F.ws + WS_CTL);
            if (li < 16) hg_mfma(F, (bf16*)FW(F, WS_Y), xg * 16 + li, hg_early ? ctl + CW_HGF : nullptr);
            else if (!hg_early) p0_deferred(F, xg * 16 + li - 16, 128);
            else { const int j = xg * 16 + li - 16;
                p0_deferred(F, j, 128, 0);
                asm volatile("s_waitcnt vmcnt(0)" ::: "memory"); __syncthreads();
                if (F.tid == 0) { __builtin_amdgcn_fence(__ATOMIC_RELEASE, "agent"); asm volatile("s_waitcnt vmcnt(0)" ::: "memory"); (void)xb_add(ctl + CW_WOF, 1u); }
                p0_deferred(F, j, 128, 1);
                __syncthreads();
                GEMM_WOUT_SCHED(SchedEarly, ({j, ctl + CW_HGF, ctl + CW_WOF, barw})); } }
        else { for (int u = F.vcu; u < BATCH * 32; u += F.G) hg_mfma(F, (bf16*)FW(F, WS_Y), u); p0_deferred(F, F.vcu, F.G); } } SEAM(13);
    if (IN(14)) { if (hg_early) GEMM_WOUT_SCHED(SchedLate, ({(int)blockIdx.x})); else GEMM_BF16(FW(F, WS_Y), FW(F, WS_W_HG_OUT), DM, FW(F, WS_YO), DM); } SEAM(14);
    if (IN(15)) { resid_phase(F, nullptr, (const bf16*)FW(F, WS_YO), FIN(F, 2) + 2 * DM, (bf16*)FW(F, WS_H), (float*)FW(F, WS_MISC + MISC_RS), nullptr); } SEAM(15);

    if (IN(16)) { GEMM_IN(FW(F, WS_W_NSA_IN + (size_t)NSA_NP * DM * 2), NSA_NP);
        if (hg_early && blockIdx.x >= 160) { __syncthreads(); p0_deferred(F, (int)blockIdx.x - 160, 96, 2); } } SEAM(16);
    if (IN(17)) { nsa_compress_mfma(F, 1); } SEAM(17);
    if (IN(18)) { nsa_attn_mfma<0>(F, (bf16*)FW(F, WS_Y)); } SEAM(18);
    if (IN(19)) { GEMM_BF16(FW(F, WS_Y), FW(F, WS_W_NSA_OUT + (size_t)DM * DM * 2), DM, FW(F, WS_YO), DM); } SEAM(19);
    if (IN(20)) { resid_phase(F, nullptr, (const bf16*)FW(F, WS_YO), FIN(F, 2) + 3 * DM, (bf16*)FW(F, WS_H), nullptr, F.out); }
#undef IN
#undef SEAM
}

extern "C" void kernel_launch(void* const* d_in, const int* in_sizes, int n_in, void* d_out, int out_size, void* d_ws, size_t ws_size, hipStream_t stream) {
    static int grid = 0;
    if (grid == 0) {
        if (n_in != 19 || out_size != MTOK * DM || ws_size < WS_END) { fprintf(stderr, "kernel_launch: unexpected shapes (n_in %d out %d ws %zu)\n", n_in, out_size, ws_size); grid = -1; return; }
        int dev = 0, cus = 0, per_cu = 0;
        if (hipGetDevice(&dev) != hipSuccess || hipDeviceGetAttribute(&cus, hipDeviceAttributeMultiprocessorCount, dev) != hipSuccess) { grid = -1; return; }
        if (hipFuncSetAttribute((const void*)fwd_kernel, hipFuncAttributeMaxDynamicSharedMemorySize, LDS_BYTES) != hipSuccess) { fprintf(stderr, "kernel_launch: hipFuncSetAttribute failed\n"); grid = -1; return; }
        if (hipOccupancyMaxActiveBlocksPerMultiprocessor(&per_cu, (const void*)fwd_kernel, NTHREADS, LDS_BYTES) != hipSuccess || per_cu < 1) { fprintf(stderr, "kernel_launch: occupancy query says %d\n", per_cu); }
        (void)hipGetLastError();
        grid = cus;
    }
    if (grid < 0) return;
    (void)hipMemsetAsync((char*)d_ws + WS_CTL, 0, CTL_ZERO_BYTES, stream);
    Args a{};
    for (int i = 0; i < 19; ++i) a.in[i] = (const float*)d_in[i];
    a.out = (float*)d_out; a.ws = (unsigned char*)d_ws; a.pad = 0;
#if MK_ONE_LAUNCH
    a.ph_lo = 0; a.ph_hi = NPHASE; a.li = 0;
    hipLaunchKernelGGL(fwd_kernel, dim3(grid), dim3(NTHREADS), LDS_BYTES, stream, a);
#else
    for (int p = 0; p < NPHASE; ++p) { a.ph_lo = p; a.ph_hi = p + 1; a.li = 0; hipLaunchKernelGGL(fwd_kernel, dim3(grid), dim3(NTHREADS), LDS_BYTES, stream, a); }
#endif
}
```

```cpp
#include <hip/hip_runtime.h>
#include <cstdio>
#include <cstdint>
namespace pg8 {
#define PG8_LAS __attribute__((address_space(3)))
typedef unsigned short bf16_t;
typedef short bf16x8 __attribute__((ext_vector_type(8)));
typedef float f32x4 __attribute__((ext_vector_type(4)));
typedef unsigned u32x4 __attribute__((ext_vector_type(4)));
constexpr int BM = 256, BK = 64, HALF = 128, HTB = HALF * BK * 2  , STAGE_BYTES = 8 * HTB, NXCD = 8, WGM = 4;

__host__ __device__ __forceinline__ int lds_byte(int r, int c) { const int st = (r >> 4) * 2 + (c >> 5), rr = r & 15, cc = c & 31, ob = rr * 64 + cc * 2; return st * 1024 + (ob ^ (((ob >> 9) & 1) << 5)); }
__host__ __device__ __forceinline__ void stage_rc(int b, int& R, int& C) { const int st = b / 1024, sb = b % 1024, swz = sb ^ (((sb >> 9) & 1) << 5); R = (st >> 1) * 16 + swz / 64; C = (st & 1) * 32 + (swz % 64) / 2; }
__host__ __device__ __forceinline__ int perm32(int rho) { const int n = rho >> 4, i = rho & 15; return 8 * (i >> 2) + 4 * n + (i & 3); }

struct Unit { int pm, pn; };
struct Gemm { const bf16_t* A; const bf16_t* Bt; int M, N, K; int lda; int ablk; };

struct StaticOrder {
    int nM, nN, nwg, G, c;
    __host__ __device__ void init(int M, int N, int G_, int c_) { nM = M / BM; nN = N / BM; nwg = nM * nN; G = G_; c = c_; }
    __host__ __device__ bool next(int i, Unit& u) const {
        const long L = (long)i * G + c; if (L >= nwg) return false;
        int wgid = (int)L; { const int q = nwg / NXCD, r = nwg % NXCD, xcd = wgid % NXCD, off = wgid / NXCD; wgid = (xcd < r ? xcd * (q + 1) : r * (q + 1) + (xcd - r) * q) + off; }
        const int nig = WGM * nN, gid = wgid / nig, fm = gid * WGM, gsz = (nM - fm) < WGM ? (nM - fm) : WGM;
        u.pm = fm + ((wgid % nig) % gsz); u.pn = (wgid % nig) / gsz; return true;
    }
    __device__ __forceinline__ void a_ready(const Unit&) const {}
    __device__ __forceinline__ void done(const Unit&) const {}
};

__device__ __forceinline__ unsigned cvt_pk_bf16(float lo, float hi) { unsigned r; asm volatile("v_cvt_pk_bf16_f32 %0, %1, %2" : "=v"(r) : "v"(lo), "v"(hi)); return r; }
typedef float f32x2 __attribute__((ext_vector_type(2)));
__device__ __forceinline__ f32x2 gelu_pk(f32x2 v) {
    const f32x2 av = __builtin_elementwise_abs(v), d = av * 0.2316418882f + 1.0f;
    f32x2 t; t.x = __builtin_amdgcn_rcpf(d.x); t.y = __builtin_amdgcn_rcpf(d.y);
    f32x2 q = t * 0.5307027145f + (-0.7265760135f); q = q * t + 0.7107068705f; q = q * t + (-0.142248368f); q = q * t + 0.127414796f; q = q * t;
    const f32x2 s = (v * v) * (-0.72134752044f);
    f32x2 e; e.x = __builtin_amdgcn_exp2f(s.x); e.y = __builtin_amdgcn_exp2f(s.y);
    const f32x2 m = v * (q * e), r = v - m;
    f32x2 o; o.x = v.x < 0.f ? m.x : r.x; o.y = v.y < 0.f ? m.y : r.y; return o;
}

template <int ACT  > struct EpiBf16 {
    static constexpr bool PERM = true, AFTER_DRAIN = false; static_assert(ACT == 0 || ACT == 1, "EpiBf16: ACT is 0 (none) or 1 (gelu_pk)");
    bf16_t* O; int ldc; const float* bias; int split_cols; size_t split_stride; float scale0;
    __device__ __forceinline__ void operator()(const f32x4 (&acc)[2][2][4][2], const Unit& u, int wr, int wc, int fr, int fq) const {
        const int row0 = u.pm * BM + wr * 64 + fr; int colt = u.pn * BM; bf16_t* base = O;
        float sc = 1.f; if (split_cols) { const int t = colt / split_cols; base += (size_t)t * split_stride; colt -= t * split_cols; if (t == 0) sc = scale0; }
        const int col0 = colt + wc * 32 + 8 * fq, bcol0 = u.pn * BM + wc * 32 + 8 * fq;
        f32x4 bv[2][2];
#pragma unroll
        for (int bj = 0; bj < 2; ++bj)
#pragma unroll
            for (int n = 0; n < 2; ++n) bv[bj][n] = bias ? *(const f32x4*)(bias + bcol0 + bj * HALF + 4 * n) : (f32x4){0.f, 0.f, 0.f, 0.f};
#pragma unroll
        for (int ai = 0; ai < 2; ++ai)
#pragma unroll
            for (int m = 0; m < 4; ++m) { bf16_t* rowp = base + (size_t)(row0 + ai * HALF + m * 16) * ldc + col0;
#pragma unroll
                for (int bj = 0; bj < 2; ++bj) { f32x4 v0 = acc[ai][bj][m][0] + bv[bj][0], v1 = acc[ai][bj][m][1] + bv[bj][1];
                    if (ACT == 1) { f32x2 a = gelu_pk((f32x2){v0[0], v0[1]}), b = gelu_pk((f32x2){v0[2], v0[3]}), c = gelu_pk((f32x2){v1[0], v1[1]}), d = gelu_pk((f32x2){v1[2], v1[3]});
                        v0 = (f32x4){a.x, a.y, b.x, b.y}; v1 = (f32x4){c.x, c.y, d.x, d.y}; }
                    v0 = v0 * sc; v1 = v1 * sc; u32x4 w; w.x = cvt_pk_bf16(v0[0], v0[1]); w.y = cvt_pk_bf16(v0[2], v0[3]); w.z = cvt_pk_bf16(v1[0], v1[1]); w.w = cvt_pk_bf16(v1[2], v1[3]);
                    *(u32x4*)(rowp + bj * HALF) = w; } }
    }
};

struct EpiBf16RS {
    static constexpr bool PERM = true, AFTER_DRAIN = false;
    bf16_t* O; int ldc; const float* rs;
    __device__ __forceinline__ void operator()(const f32x4 (&acc)[2][2][4][2], const Unit& u, int wr, int wc, int fr, int fq) const {
        const int row0 = u.pm * BM + wr * 64 + fr, col0 = u.pn * BM + wc * 32 + 8 * fq;
        float scv[2][4];
#pragma unroll
        for (int ai = 0; ai < 2; ++ai)
#pragma unroll
            for (int m = 0; m < 4; ++m) scv[ai][m] = rs[row0 + ai * HALF + m * 16];
#pragma unroll
        for (int ai = 0; ai < 2; ++ai)
#pragma unroll
            for (int m = 0; m < 4; ++m) { const int row = row0 + ai * HALF + m * 16; const float sc = scv[ai][m]; bf16_t* rowp = O + (size_t)row * ldc + col0;
#pragma unroll
                for (int bj = 0; bj < 2; ++bj) { const f32x4 v0 = acc[ai][bj][m][0] * sc, v1 = acc[ai][bj][m][1] * sc;
                    u32x4 w; w.x = cvt_pk_bf16(v0[0], v0[1]); w.y = cvt_pk_bf16(v0[2], v0[3]); w.z = cvt_pk_bf16(v1[0], v1[1]); w.w = cvt_pk_bf16(v1[2], v1[3]);
                    *(u32x4*)(rowp + bj * HALF) = w; } }
    }
};

template <class Epi, class Sched, bool ALIGN_EPI = false, bool SP2 = false>
__device__ __forceinline__ void gemm_phase(PG8_LAS unsigned char* lds, const Gemm g, const Sched& S, const Epi& E) {
    const int tid = threadIdx.x, wid = __builtin_amdgcn_readfirstlane(tid >> 6), lane = tid & 63, wr = wid >> 2, wc = wid & 3, fr = lane & 15, fq = lane >> 4;
    const int K = g.K, nt = K / BK;
    unsigned voffA[2], voffB[2];
#pragma unroll
    for (int i = 0; i < 2; ++i) { int R, C; stage_rc(tid * 16 + i * 8192, R, C); const int Rb = Epi::PERM ? ((R & ~31) + perm32(R & 31)) : R;
        voffA[i] = (unsigned)(R * g.lda + C) * 2u; voffB[i] = (unsigned)(Rb * K + C) * 2u; }
    const size_t kstep = (size_t)(BK * 2);
    const size_t hstepB = (size_t)HALF * K * 2, hstepA = (size_t)HALF * g.lda * 2;
    const size_t tstepB = 2 * hstepB, tstepA = 2 * hstepA;
#define PG8_ACOL(pn_) (g.ablk ? (size_t)((pn_) >> 1) * 512u : (size_t)0)
    const unsigned ldsw = (unsigned)wid * 1024u;
    const int aoff = lds_byte(wr * 64 + fr, fq * 8), boff = lds_byte(wc * 32 + fr, fq * 8);
#define PG8_SA(b, h) (((b) * 2 + (h)) * HTB)
#define PG8_SB(b, h) ((4 + (b) * 2 + (h)) * HTB)
#define PG8_STAGE(bufoff, gbase, voff) do { _Pragma("unroll") for (int _i = 0; _i < 2; ++_i) \
        __builtin_amdgcn_global_load_lds((const unsigned*)((const char*)(gbase) + (voff)[_i]), (PG8_LAS unsigned*)(lds + (bufoff) + ldsw + _i * 8192), 16, 0, 0); } while (0)
#define PG8_LDA(dst, b, h) do { _Pragma("unroll") for (int m = 0; m < 4; ++m) _Pragma("unroll") for (int k = 0; k < 2; ++k) dst[m][k] = *(const PG8_LAS bf16x8*)(lds + PG8_SA(b, h) + aoff + m * 2048 + k * 1024); } while (0)
#define PG8_LDB(dst, b, h) do { _Pragma("unroll") for (int n = 0; n < 2; ++n) _Pragma("unroll") for (int k = 0; k < 2; ++k) dst[n][k] = *(const PG8_LAS bf16x8*)(lds + PG8_SB(b, h) + boff + n * 2048 + k * 1024); } while (0)
#define PG8_MMA(ai, bj, At, Bt) do { __builtin_amdgcn_s_setprio(1); _Pragma("unroll") for (int m = 0; m < 4; ++m) _Pragma("unroll") for (int n = 0; n < 2; ++n) _Pragma("unroll") for (int k = 0; k < 2; ++k) \
        acc[ai][bj][m][n] = __builtin_amdgcn_mfma_f32_16x16x32_bf16(Bt[n][k], At[m][k], acc[ai][bj][m][n], 0, 0, 0); __builtin_amdgcn_s_setprio(0); } while (0)
#define PG8_WAIT_V(n) asm volatile("s_waitcnt vmcnt(" #n ")" ::: "memory")
#define PG8_WAIT_L(n) asm volatile("s_waitcnt lgkmcnt(" #n ")" ::: "memory")
#define PG8_BAR __builtin_amdgcn_s_barrier()
#define PG8_SCHED __builtin_amdgcn_sched_barrier(0)
    Unit cur, nxt; int ui = 0;
    if (!S.next(0, cur)) return;
    f32x4 acc[2][2][4][2];
#pragma unroll
    for (int a = 0; a < 2; ++a)
#pragma unroll
        for (int b = 0; b < 2; ++b)
#pragma unroll
            for (int m = 0; m < 4; ++m)
#pragma unroll
                for (int n = 0; n < 2; ++n) acc[a][b][m][n] = (f32x4){0.f, 0.f, 0.f, 0.f};
    bf16x8 At[4][2], B0[2][2], B1[2][2];
    const char* cA = (const char*)g.A + (size_t)cur.pm * tstepA + PG8_ACOL(cur.pn); const char* cB = (const char*)g.Bt + (size_t)cur.pn * tstepB;
    S.a_ready(cur);
    if constexpr (SP2) {
        PG8_STAGE(PG8_SB(0, 0), cB, voffB); PG8_STAGE(PG8_SB(0, 1), cB + hstepB, voffB); PG8_STAGE(PG8_SA(0, 0), cA, voffA); PG8_STAGE(PG8_SA(0, 1), cA + hstepA, voffA);
        if (wr == 1) PG8_BAR;
        PG8_WAIT_V(2); PG8_BAR;
        PG8_STAGE(PG8_SB(1, 0), cB + kstep, voffB); PG8_STAGE(PG8_SA(1, 0), cA + kstep, voffA); PG8_STAGE(PG8_SB(1, 1), cB + hstepB + kstep, voffB);
        PG8_WAIT_V(6); PG8_BAR;
    } else {
        PG8_STAGE(PG8_SB(0, 0), cB, voffB); PG8_STAGE(PG8_SA(0, 0), cA, voffA); PG8_STAGE(PG8_SB(0, 1), cB + hstepB, voffB); PG8_STAGE(PG8_SA(0, 1), cA + hstepA, voffA);
        if (wr == 1) PG8_BAR;
        PG8_WAIT_V(4); PG8_BAR;
        PG8_STAGE(PG8_SB(1, 0), cB + kstep, voffB); PG8_STAGE(PG8_SA(1, 0), cA + kstep, voffA); PG8_STAGE(PG8_SB(1, 1), cB + hstepB + kstep, voffB);
        PG8_WAIT_V(6); PG8_BAR;
    }
    for (;;) {
        const bool has_next = S.next(ui + 1, nxt);
        const char* nA = has_next ? (const char*)g.A + (size_t)nxt.pm * tstepA + PG8_ACOL(nxt.pn) : cA; const char* nB = has_next ? (const char*)g.Bt + (size_t)nxt.pn * tstepB : cB;
        for (int t = 0; t < nt; t += 2) {
            const bool last = (t == nt - 2);
            const char* a1 = cA + (size_t)(t + 1) * kstep;
            const char* a2 = last ? nA : cA + (size_t)(t + 2) * kstep; const char* b2 = last ? nB : cB + (size_t)(t + 2) * kstep;
            const char* a3 = a2 + kstep; const char* b3 = b2 + kstep;
            if (last && has_next) S.a_ready(nxt);
            if constexpr (SP2) {
            PG8_LDB(B0, 0, 0); PG8_LDB(B1, 0, 1); PG8_SCHED; PG8_LDA(At, 0, 0); PG8_STAGE(PG8_SA(1, 1), a1 + hstepA, voffA);
            PG8_WAIT_V(8); PG8_WAIT_L(0); PG8_BAR; PG8_MMA(0, 0, At, B0); PG8_MMA(0, 1, At, B1); PG8_BAR; PG8_SCHED;
            PG8_LDA(At, 0, 1); PG8_STAGE(PG8_SB(0, 0), b2, voffB); PG8_STAGE(PG8_SB(0, 1), b2 + hstepB, voffB); PG8_STAGE(PG8_SA(0, 0), a2, voffA);
            PG8_WAIT_V(8); PG8_WAIT_L(0); PG8_BAR; PG8_MMA(1, 0, At, B0); PG8_MMA(1, 1, At, B1); PG8_BAR; PG8_SCHED;
            PG8_LDB(B0, 1, 0); PG8_LDB(B1, 1, 1); PG8_SCHED; PG8_LDA(At, 1, 0); PG8_STAGE(PG8_SA(0, 1), a2 + hstepA, voffA);
            PG8_WAIT_V(8); PG8_WAIT_L(0); PG8_BAR; PG8_MMA(0, 0, At, B0); PG8_MMA(0, 1, At, B1); PG8_BAR; PG8_SCHED;
            PG8_LDA(At, 1, 1); PG8_STAGE(PG8_SB(1, 0), b3, voffB); PG8_STAGE(PG8_SB(1, 1), b3 + hstepB, voffB); PG8_STAGE(PG8_SA(1, 0), a3, voffA);
            PG8_WAIT_V(8); PG8_WAIT_L(0); PG8_BAR; PG8_MMA(1, 0, At, B0); PG8_MMA(1, 1, At, B1); PG8_BAR; PG8_SCHED;
            } else {
            PG8_LDB(B0, 0, 0); PG8_SCHED; PG8_LDA(At, 0, 0); PG8_STAGE(PG8_SA(1, 1), a1 + hstepA, voffA);
            PG8_WAIT_L(8); PG8_BAR; PG8_WAIT_L(0); PG8_MMA(0, 0, At, B0); PG8_BAR; PG8_SCHED;
            PG8_LDB(B1, 0, 1); PG8_STAGE(PG8_SB(0, 0), b2, voffB);
            PG8_BAR; PG8_WAIT_L(0); PG8_MMA(0, 1, At, B1); PG8_BAR;
            PG8_LDA(At, 0, 1); PG8_STAGE(PG8_SA(0, 0), a2, voffA);
            PG8_BAR; PG8_WAIT_L(0); PG8_MMA(1, 0, At, B0); PG8_BAR; PG8_SCHED;
            PG8_STAGE(PG8_SB(0, 1), b2 + hstepB, voffB);
            PG8_WAIT_V(6); PG8_BAR; PG8_MMA(1, 1, At, B1); PG8_BAR;
            PG8_LDB(B0, 1, 0); PG8_SCHED; PG8_LDA(At, 1, 0); PG8_STAGE(PG8_SA(0, 1), a2 + hstepA, voffA);
            PG8_WAIT_L(8); PG8_BAR; PG8_WAIT_L(0); PG8_MMA(0, 0, At, B0); PG8_BAR; PG8_SCHED;
            PG8_LDB(B1, 1, 1); PG8_STAGE(PG8_SB(1, 0), b3, voffB);
            PG8_BAR; PG8_WAIT_L(0); PG8_MMA(0, 1, At, B1); PG8_BAR;
            PG8_LDA(At, 1, 1); PG8_STAGE(PG8_SA(1, 0), a3, voffA);
            PG8_BAR; PG8_WAIT_L(0); PG8_MMA(1, 0, At, B0); PG8_BAR; PG8_SCHED;
            PG8_STAGE(PG8_SB(1, 1), b3 + hstepB, voffB);
            PG8_WAIT_V(6); PG8_BAR; PG8_MMA(1, 1, At, B1); PG8_BAR;
            }
        }
        if constexpr (ALIGN_EPI) { if (wr == 0) PG8_BAR; }
        if constexpr (!Epi::AFTER_DRAIN) { E(acc, cur, wr, wc, fr, fq); S.done(cur); }
        if (!has_next) break;
#pragma unroll
        for (int a = 0; a < 2; ++a)
#pragma unroll
            for (int b = 0; b < 2; ++b)
#pragma unroll
                for (int m = 0; m < 4; ++m)
#pragma unroll
                    for (int n = 0; n < 2; ++n) acc[a][b][m][n] = (f32x4){0.f, 0.f, 0.f, 0.f};
        cur = nxt; cA = nA; cB = nB; ++ui;
        if constexpr (ALIGN_EPI) { if (wr == 1) PG8_BAR; }
    }
    PG8_WAIT_V(0);
    if constexpr (!ALIGN_EPI) { if (wr == 0) PG8_BAR; }
    PG8_BAR;
    if constexpr (Epi::AFTER_DRAIN) { E.fused(acc, cur, wr, wc, fr, fq, lds, wid, lane); S.done(cur); }
#undef PG8_ACOL
#undef PG8_SA
#undef PG8_SB
#undef PG8_STAGE
#undef PG8_LDA
#undef PG8_LDB
#undef PG8_MMA
#undef PG8_WAIT_V
#undef PG8_WAIT_L
#undef PG8_BAR
#undef PG8_SCHED
}
}

constexpr int BATCH = 4, SEQ = 2048, DM = 4096, MTOK = BATCH * SEQ;
constexpr int NSA_NP = 11520;
constexpr int NSA_Q = 0, NSA_KC = 4096, NSA_VC = 4608, NSA_KS = 5120, NSA_VS = 5632, NSA_KW = 6144, NSA_VW = 6656, NSA_Z = 7168, NSA_GL = 11264;
constexpr int RG_NP = 8192, HG_NP = 16384;
constexpr float NORM_EPS = 1e-6f;
constexpr int NWAVES = 8, NTHREADS = 512;

constexpr size_t MiB = 1u << 20;
constexpr size_t WS_CTL = 0, CTL_ZERO_BYTES = 32768;
constexpr size_t WS_W_NSA_IN = 2 * MiB;
constexpr size_t WS_W_NSA_OUT = 182 * MiB;
constexpr size_t WS_W_RG_IN = 246 * MiB;
constexpr size_t WS_W_RG_OUT = 310 * MiB;
constexpr size_t WS_W_HG_IN = 342 * MiB;
constexpr size_t WS_W_HG_OUT = 470 * MiB;
constexpr size_t WS_MISC = 502 * MiB;
constexpr size_t WS_H = 512 * MiB;
constexpr size_t WS_PROJ = 576 * MiB;
constexpr size_t WS_Y = 832 * MiB;
constexpr size_t WS_YO = 896 * MiB;
constexpr size_t WS_SCR = 960 * MiB;
constexpr size_t WS_END = 1216 * MiB;
constexpr size_t MISC_LB = 9 * MiB;
constexpr size_t MISC_SP = 9 * MiB + 65536;
constexpr size_t MISC_RS = 9 * MiB + 131072;
constexpr size_t MISC_GATE = 0;
constexpr int CW_BAR = 4096;

constexpr int RING_OFF = 0, RING_BYTES = 131072;
constexpr int LDS_BYTES = 163840;
constexpr int MISC_OFF = LDS_BYTES - 256;

#define LAS __attribute__((address_space(3)))
typedef unsigned short bf16;
typedef unsigned v4u __attribute__((ext_vector_type(4)));
typedef unsigned v2u __attribute__((ext_vector_type(2)));
typedef float v4f __attribute__((ext_vector_type(4)));
typedef float v2f __attribute__((ext_vector_type(2)));

__device__ __forceinline__ float bf2f(unsigned b) { return __uint_as_float(b << 16); }
__device__ __forceinline__ float bflo(unsigned w) { return __uint_as_float(w << 16); }
__device__ __forceinline__ float bfhi(unsigned w) { return __uint_as_float(w & 0xffff0000u); }
__device__ __forceinline__ unsigned f2bf(float f) { unsigned u = __float_as_uint(f); return (u + 0x7fffu + ((u >> 16) & 1u)) >> 16; }
__device__ __forceinline__ unsigned pk2(float lo, float hi) { unsigned r; asm volatile("v_cvt_pk_bf16_f32 %0, %1, %2" : "=v"(r) : "v"(lo), "v"(hi)); return r; }
__device__ __forceinline__ float wave_sum(float v) {
#pragma unroll
    for (int o = 1; o < 64; o <<= 1) v += __shfl_xor(v, o);
    return v;
}
__device__ __forceinline__ float wave_max(float v) {
#pragma unroll
    for (int o = 1; o < 64; o <<= 1) v = fmaxf(v, __shfl_xor(v, o));
    return v;
}
__device__ __forceinline__ float sigmoidf_(float x) { return __builtin_amdgcn_rcpf(1.0f + __expf(-x)); }
__device__ __forceinline__ float siluf_(float x) { return x * __builtin_amdgcn_rcpf(1.0f + __expf(-x)); }
#define XB_TMO      128
#define XB_XCNT(j)  (256  + 64 * (j))
#define XB_XSUB(j)  (1280 + 64 * (j))
#define XB_XGEN(j)  (2304 + 64 * (j))
#define XB_TOP      3328
#define XB_TOPGEN   3392
#define XCD_BAR_WORDS 3456
#define XB_SPIN_CAP (1u << 18)

__device__ __forceinline__ unsigned xb_ld(unsigned* p)              { return __hip_atomic_load(p, __ATOMIC_RELAXED, __HIP_MEMORY_SCOPE_AGENT); }
__device__ __forceinline__ unsigned xb_add(unsigned* p, unsigned v) { return __hip_atomic_fetch_add(p, v, __ATOMIC_RELAXED, __HIP_MEMORY_SCOPE_AGENT); }
__device__ __forceinline__ unsigned xb_xcc_id() { return (unsigned)__builtin_amdgcn_s_getreg((3 << 11) | 20) & 0xFu; }
#define XB_SPIN(cond, bar) do { unsigned _sp = 0; while (cond) { __builtin_amdgcn_s_sleep(1); \
    if ((++_sp & 255u) == 0u) { if (xb_ld(&(bar)[XB_TMO])) break; if (_sp > XB_SPIN_CAP) { atomicAdd(&(bar)[XB_TMO], 1u); break; } } } } while (0)

struct XcdBarrier {
    unsigned* bar; unsigned x;
    volatile LAS unsigned* st;
};

__device__ __forceinline__ XcdBarrier xcd_barrier_post(unsigned* bar, volatile LAS unsigned* st) {
    XcdBarrier b; b.bar = bar; b.x = xb_xcc_id(); b.st = st;
    if (threadIdx.x == 0) (void)xb_add(&bar[XB_XCNT(b.x)], 1u);
    return b;
}
__device__ __forceinline__ void xcd_barrier_complete(unsigned* bar, unsigned x, unsigned& nloc, unsigned& nx) {
    const unsigned G = gridDim.x * gridDim.y * gridDim.z;
    unsigned sum, cnt, mine, sp = 0u;
    for (;;) {
        sum = 0u; cnt = 0u; mine = 0u;
#pragma unroll
        for (unsigned j = 0; j < 16; ++j) { const unsigned c = xb_ld(&bar[XB_XCNT(j)]); sum += c; cnt += (c > 0u) ? 1u : 0u; mine = (j == x) ? c : mine; }
        if (sum == G) break;
        __builtin_amdgcn_s_sleep(1);
        if ((++sp & 255u) == 0u) { if (xb_ld(&bar[XB_TMO])) break; if (sp > XB_SPIN_CAP) { atomicAdd(&bar[XB_TMO], 1u); break; } }
    }
    nloc = mine > 0u ? mine : 1u; nx = cnt > 0u ? cnt : 1u;
}

__device__ __forceinline__ void xcd_barrier(const XcdBarrier& b) {
    asm volatile("s_waitcnt vmcnt(0)" ::: "memory");
    __syncthreads();
    if (threadIdx.x == 0) {
        unsigned* bar = b.bar;
        __builtin_amdgcn_s_waitcnt(0);
        unsigned nloc = b.st[0], nx = b.st[1];
        if (nloc == 0u) { xcd_barrier_complete(bar, b.x, nloc, nx); b.st[0] = nloc; b.st[1] = nx; }
        const unsigned old = xb_add(&bar[XB_XSUB(b.x)], 1u);
        const unsigned gen = old / nloc;
        if (old + 1u == (gen + 1u) * nloc) {
            __builtin_amdgcn_fence(__ATOMIC_RELEASE, "agent");
            asm volatile("s_waitcnt vmcnt(0)" ::: "memory");
            const unsigned og = xb_add(&bar[XB_TOP], 1u);
            const unsigned tg = og / nx;
            if (og + 1u == (tg + 1u) * nx) xb_add(&bar[XB_TOPGEN], 1u);
            else XB_SPIN(xb_ld(&bar[XB_TOPGEN]) == tg, bar);
            __builtin_amdgcn_fence(__ATOMIC_ACQUIRE, "agent");
            xb_add(&bar[XB_XGEN(b.x)], 1u);
            asm volatile("s_waitcnt vmcnt(0)" ::: "memory");
        } else {
            XB_SPIN(xb_ld(&bar[XB_XGEN(b.x)]) == gen, bar);
            __builtin_amdgcn_fence(__ATOMIC_ACQUIRE, "agent");
            asm volatile("s_waitcnt vmcnt(0)" ::: "memory");
        }
    }
    __syncthreads();
}

struct Frame {
    unsigned char* lds;
    int tid, lane, wave;
    int vcu, G;
    int gw, ngw;
    const float* const __attribute__((address_space(4)))* kin;
    float* out;
    unsigned char* ws;
};
#define FW(F, off) ((F).ws + (off))
#define FIN(F, i) ((F).kin[i])

__device__ __forceinline__ void p0_transpose_item(const float* W, int K, int N, bf16* WT, int kb, int src_col0, int dst_row0, float* scr, int lane, const float* kgain = nullptr) {
    const int k0 = 64 * kb, c = lane & 7;
    v4f g0 = (v4f){1.f, 1.f, 1.f, 1.f}, g1 = g0;
    if (src_col0 >= 0) {
        float wv[32];
        if (kgain) { g0 = *(const v4f*)(kgain + k0 + 8 * c); g1 = *(const v4f*)(kgain + k0 + 8 * c + 4); }
#pragma unroll
        for (int i = 0; i < 32; ++i) { const int kk = 2 * i + (lane >> 5); wv[i] = __builtin_nontemporal_load(&W[(size_t)(k0 + kk) * N + src_col0 + (lane & 31)]); }
#pragma unroll
        for (int i = 0; i < 32; ++i) { const int kk = 2 * i + (lane >> 5); scr[kk * 33 + (lane & 31)] = wv[i]; }
    }
    __builtin_amdgcn_s_waitcnt(0xC07F); asm volatile("" ::: "memory");
#pragma unroll
    for (int j = 0; j < 4; ++j) { const int n = (lane >> 3) + 8 * j; const float* s = scr + (8 * c) * 33 + n;
        v4u o;
        if (src_col0 >= 0) { o.x = pk2(s[0 * 33] * g0.x, s[1 * 33] * g0.y); o.y = pk2(s[2 * 33] * g0.z, s[3 * 33] * g0.w); o.z = pk2(s[4 * 33] * g1.x, s[5 * 33] * g1.y); o.w = pk2(s[6 * 33] * g1.z, s[7 * 33] * g1.w); }
        else { o.x = 0u; o.y = 0u; o.z = 0u; o.w = 0u; }
        *(v4u*)(WT + (size_t)(dst_row0 + n) * K + k0 + 8 * c) = o; }
    __builtin_amdgcn_s_waitcnt(0xC07F); asm volatile("" ::: "memory");
}
template <class CM, class RM>
__device__ __forceinline__ void p0_transpose_matrix2(Frame& F, const float* W, int K, int N, bf16* WT, int nblk, CM colmap, RM rowmap, int& it0, const float* kgain = nullptr) {
    float* scr = (float*)(F.lds + RING_OFF + F.wave * 16384);
    const int nitems = (K / 64) * nblk;
    int first = (F.gw - (it0 % F.ngw) + F.ngw) % F.ngw;
    for (int r = first; r < nitems; r += F.ngw) {
        const int kb = r / nblk, nb = r % nblk;
        p0_transpose_item(W, K, N, WT, kb, colmap(nb), rowmap(nb), scr, F.lane, kgain);
    }
    it0 += nitems;
}
template <class CM>
__device__ __forceinline__ void p0_transpose_matrix(Frame& F, const float* W, int K, int N, bf16* WT, int nblk, CM colmap, int& it0, const float* kgain = nullptr) {
    float* scr = (float*)(F.lds + RING_OFF + F.wave * 16384);
    const int nitems = (K / 64) * nblk;
    int first = (F.gw - (it0 % F.ngw) + F.ngw) % F.ngw;
    for (int r = first; r < nitems; r += F.ngw) {
        const int kb = r / nblk, nb = r % nblk;
        p0_transpose_item(W, K, N, WT, kb, colmap(nb), nb * 32, scr, F.lane, kgain);
    }
    it0 += nitems;
}

#define OPQ(p) asm volatile("" : "+v"(p))
__device__ __forceinline__ void resid_phase(Frame& F, const float* xin32, const bf16* yo, const float* post_gain, bf16* XB, float* RS, float* out32) {
    for (int row = F.gw; row < MTOK; row += F.ngw) {
        v4f v[16];
        if (xin32) {
#pragma unroll
            for (int q = 0; q < 4; ++q) { const v4f* p = (const v4f*)(xin32 + (size_t)row * DM) + F.lane + 256 * q; OPQ(p);
#pragma unroll
                for (int jj = 0; jj < 4; ++jj) v[4 * q + jj] = p[64 * jj]; }
        } else {
#pragma unroll
            for (int q = 0; q < 4; ++q) { const v2u* p = (const v2u*)(XB + (size_t)row * DM) + F.lane + 256 * q; OPQ(p);
#pragma unroll
                for (int jj = 0; jj < 4; ++jj) { const v2u w = p[64 * jj]; v[4 * q + jj] = (v4f){bflo(w.x), bfhi(w.x), bflo(w.y), bfhi(w.y)}; } }
        }
        if (yo) {
            v2u y[16]; float ss = 0.f;
#pragma unroll
            for (int q = 0; q < 4; ++q) { const v2u* p = (const v2u*)(yo + (size_t)row * DM) + F.lane + 256 * q; OPQ(p);
#pragma unroll
                for (int jj = 0; jj < 4; ++jj) { const int j = 4 * q + jj; y[j] = p[64 * jj]; const float a = bflo(y[j].x), b = bfhi(y[j].x), c = bflo(y[j].y), d = bfhi(y[j].y); ss += (a * a + b * b) + (c * c + d * d); } }
            const float rstd = rsqrtf(wave_sum(ss) * (1.f / DM) + NORM_EPS);
#pragma unroll
            for (int q = 0; q < 4; ++q) { const v4f* gp = (const v4f*)post_gain + F.lane + 256 * q; OPQ(gp);
#pragma unroll
                for (int jj = 0; jj < 4; ++jj) { const int j = 4 * q + jj; const v4f g = gp[64 * jj];
                    v[j].x += bflo(y[j].x) * rstd * g.x; v[j].y += bfhi(y[j].x) * rstd * g.y; v[j].z += bflo(y[j].y) * rstd * g.z; v[j].w += bfhi(y[j].y) * rstd * g.w; } }
        }
        if (out32) {
#pragma unroll
            for (int q = 0; q < 4; ++q) { v4f* xo = (v4f*)(out32 + (size_t)row * DM) + F.lane + 256 * q; OPQ(xo);
#pragma unroll
                for (int jj = 0; jj < 4; ++jj) xo[64 * jj] = v[4 * q + jj]; }
        } else {
            float ss = 0.f;
#pragma unroll
            for (int j = 0; j < 16; ++j) ss += (v[j].x * v[j].x + v[j].y * v[j].y) + (v[j].z * v[j].z + v[j].w * v[j].w);
            const float rstd = rsqrtf(wave_sum(ss) * (1.f / DM) + NORM_EPS);
            if (F.lane == 0) RS[row] = rstd;
#pragma unroll
            for (int q = 0; q < 4; ++q) { v2u* ho = (v2u*)(XB + (size_t)row * DM) + F.lane + 256 * q; OPQ(ho);
#pragma unroll
                for (int jj = 0; jj < 4; ++jj) { const int j = 4 * q + jj; v2u o; o.x = pk2(v[j].x, v[j].y); o.y = pk2(v[j].z, v[j].w); ho[64 * jj] = o; } }
        }
    }
}

__device__ __forceinline__ void p0_prologue(Frame& F, bool split = false) {
    int it0 = 0;
    if (!split) {
    p0_transpose_matrix(F, FIN(F, 3), DM, 11360, (bf16*)FW(F, WS_W_NSA_IN), NSA_NP / 32,
        [](int nb) { const int n = nb * 32; return n < 7168 ? n : (n < 11264 ? n + 96 : (n < 11360 ? n - 4096 : -1)); }, it0, FIN(F, 1) + 0 * DM);
    p0_transpose_matrix(F, FIN(F, 7), DM, DM, (bf16*)FW(F, WS_W_NSA_OUT), DM / 32, [](int nb) { return nb * 32; }, it0);
    if (F.G != 256) p0_transpose_matrix(F, FIN(F, 8), DM, RG_NP, (bf16*)FW(F, WS_W_RG_IN), RG_NP / 32, [](int nb) { return nb * 32; }, it0, FIN(F, 1) + 1 * DM);
    p0_transpose_matrix(F, FIN(F, 14), DM, DM, (bf16*)FW(F, WS_W_RG_OUT), DM / 32, [](int nb) { return nb * 32; }, it0);
    p0_transpose_matrix(F, FIN(F, 15), DM, HG_NP, (bf16*)FW(F, WS_W_HG_IN), HG_NP / 32, [](int nb) { return nb * 32; }, it0, FIN(F, 1) + 2 * DM);
    for (int kn = 0; kn < 32; ++kn) { const int k = kn >> 4, n = kn & 15;
        p0_transpose_matrix2(F, FIN(F, 11) + (size_t)kn * 256 * 256, 256, 256, (bf16*)FW(F, WS_MISC + MISC_GATE), 8, [](int nb) { return nb * 32; },
            [=](int nb) { const int e0 = nb * 32; return (2 * n + (e0 >> 7)) * 256 + (e0 & 127) + 128 * k; }, it0); }
    for (int lw = 0; lw < 4; ++lw) {
        p0_transpose_matrix(F, FIN(F, 5) + (size_t)lw * 4096 * 128, 4096, 128, (bf16*)FW(F, WS_MISC + 4 * MiB) + (size_t)lw * 128 * 4096, 4, [](int nb) { return nb * 32; }, it0);
        p0_transpose_matrix(F, FIN(F, 6) + (size_t)lw * 128 * 128, 128, 128, (bf16*)FW(F, WS_MISC + 8 * MiB) + (size_t)lw * 128 * 128, 4, [](int nb) { return nb * 32; }, it0); }
    }
    { const int c = F.vcu * NTHREADS + F.tid;
      if (c < DM) { const float l = FIN(F, 13)[c]; ((float*)FW(F, WS_MISC + MISC_SP))[c] = (-l > 20.f) ? -l : log1pf(expf(-l)); } }
    { const int c = F.vcu * NTHREADS + F.tid;
      if (c < DM) { const float* lg = FIN(F, 16); const float a0 = lg[c], a1 = lg[DM + c], a2 = lg[2 * DM + c], a3 = lg[3 * DM + c];
          const float mx = fmaxf(fmaxf(a0, a1), fmaxf(a2, a3)); const float e0 = expf(a0 - mx), e1 = expf(a1 - mx), e2 = expf(a2 - mx), e3 = expf(a3 - mx);
          ((float*)FW(F, WS_MISC + MISC_LB))[c] = (e1 + e2) / (e0 + e1 + e2 + e3); } }
    resid_phase(F, FIN(F, 0), nullptr, nullptr, (bf16*)FW(F, WS_H), (float*)FW(F, WS_MISC + MISC_RS), nullptr);
}
constexpr int P_HG_SPLIT = 256;
__device__ __forceinline__ void p0_split_tail(Frame& F, int my, int nconv) {
    const int gw0 = F.gw, ngw0 = F.ngw; F.gw = my * NWAVES + F.wave; F.ngw = nconv * NWAVES;
    int it0 = 0;
    p0_transpose_matrix2(F, FIN(F, 15), DM, HG_NP, (bf16*)FW(F, WS_W_HG_IN), HG_NP / 32 - P_HG_SPLIT, [](int nb) { return (P_HG_SPLIT + nb) * 32; }, [](int nb) { return (P_HG_SPLIT + nb) * 32; }, it0, FIN(F, 1) + 2 * DM);
    F.gw = gw0; F.ngw = ngw0;
}
__device__ __forceinline__ void p0_post(Frame& F, unsigned* cnt) {
    asm volatile("s_waitcnt vmcnt(0)" ::: "memory"); __syncthreads();
    if (F.tid == 0) { __builtin_amdgcn_fence(__ATOMIC_RELEASE, "agent"); asm volatile("s_waitcnt vmcnt(0)" ::: "memory"); (void)xb_add(cnt, 1u); }
}
__device__ __forceinline__ void p0_split_convert(Frame& F, int my, int nconv, unsigned* flag) {
    const int gw0 = F.gw, ngw0 = F.ngw; F.gw = my * NWAVES + F.wave; F.ngw = nconv * NWAVES;
    int it0 = 0;
    auto cm = [](int nb) { const int n = nb * 32; return n < 7168 ? n : (n < 11264 ? n + 96 : (n < 11360 ? n - 4096 : -1)); };
    for (int gq = 0; gq < 2; ++gq) {
        p0_transpose_matrix2(F, FIN(F, 3), DM, 11360, (bf16*)FW(F, WS_W_NSA_IN), 32, [=](int nb) { return cm(32 * gq + nb); }, [=](int nb) { return (32 * gq + nb) * 32; }, it0, FIN(F, 1) + 0 * DM);
        p0_post(F, flag + gq); }
    p0_transpose_matrix2(F, FIN(F, 3), DM, 11360, (bf16*)FW(F, WS_W_NSA_IN), NSA_NP / 32 - 64, [=](int nb) { return cm(64 + nb); }, [=](int nb) { return (64 + nb) * 32; }, it0, FIN(F, 1) + 0 * DM);
    p0_transpose_matrix(F, FIN(F, 7), DM, DM, (bf16*)FW(F, WS_W_NSA_OUT), DM / 32, [](int nb) { return nb * 32; }, it0);
    p0_transpose_matrix(F, FIN(F, 14), DM, DM, (bf16*)FW(F, WS_W_RG_OUT), DM / 32, [](int nb) { return nb * 32; }, it0);
    p0_transpose_matrix(F, FIN(F, 15), DM, HG_NP, (bf16*)FW(F, WS_W_HG_IN), P_HG_SPLIT, [](int nb) { return nb * 32; }, it0, FIN(F, 1) + 2 * DM);
    for (int kn = 0; kn < 32; ++kn) { const int k = kn >> 4, n = kn & 15;
        p0_transpose_matrix2(F, FIN(F, 11) + (size_t)kn * 256 * 256, 256, 256, (bf16*)FW(F, WS_MISC + MISC_GATE), 8, [](int nb) { return nb * 32; },
            [=](int nb) { const int e0 = nb * 32; return (2 * n + (e0 >> 7)) * 256 + (e0 & 127) + 128 * k; }, it0); }
    for (int lw = 0; lw < 4; ++lw) {
        p0_transpose_matrix(F, FIN(F, 5) + (size_t)lw * 4096 * 128, 4096, 128, (bf16*)FW(F, WS_MISC + 4 * MiB) + (size_t)lw * 128 * 4096, 4, [](int nb) { return nb * 32; }, it0);
        p0_transpose_matrix(F, FIN(F, 6) + (size_t)lw * 128 * 128, 128, 128, (bf16*)FW(F, WS_MISC + 8 * MiB) + (size_t)lw * 128 * 128, 4, [](int nb) { return nb * 32; }, it0); }
    F.gw = gw0; F.ngw = ngw0;
}

__device__ __forceinline__ void p0_rg_in(Frame& F, int my, int nconv) {
    const int gw0 = F.gw, ngw0 = F.ngw; F.gw = my * NWAVES + F.wave; F.ngw = nconv * NWAVES;
    int it0 = 0;
    p0_transpose_matrix(F, FIN(F, 8), DM, RG_NP, (bf16*)FW(F, WS_W_RG_IN), RG_NP / 32, [](int nb) { return nb * 32; }, it0, FIN(F, 1) + 1 * DM);
    F.gw = gw0; F.ngw = ngw0;
}
__device__ __forceinline__ void p0_deferred(Frame& F, int my, int nconv, int part = -1) {
    const int gw0 = F.gw, ngw0 = F.ngw; F.gw = my * NWAVES + F.wave; F.ngw = nconv * NWAVES;
    int it0 = 0;
    if (part < 0 || part == 0) p0_transpose_matrix(F, FIN(F, 18), DM, DM, (bf16*)FW(F, WS_W_HG_OUT), DM / 32, [](int nb) { return nb * 32; }, it0);
    if (part < 0 || part == 1) p0_transpose_matrix(F, FIN(F, 3) + (size_t)DM * 11360, DM, 11360, (bf16*)FW(F, WS_W_NSA_IN) + (size_t)NSA_NP * DM, NSA_NP / 32,
        [](int nb) { const int n = nb * 32; return n < 7168 ? n : (n < 11264 ? n + 96 : (n < 11360 ? n - 4096 : -1)); }, it0, FIN(F, 1) + 3 * DM);
    if (part < 0 || part == 2) p0_transpose_matrix(F, FIN(F, 7) + (size_t)DM * DM, DM, DM, (bf16*)FW(F, WS_W_NSA_OUT) + (size_t)DM * DM, DM / 32, [](int nb) { return nb * 32; }, it0);
    F.gw = gw0; F.ngw = ngw0;
}

__device__ __forceinline__ float gelu_tanh(float x) { return 0.5f * x * (1.f + tanhf(0.7978845608028654f * (x + 0.044715f * x * x * x))); }

__device__ __forceinline__ void nsa_compress_naive(Frame& F, int j) {
    const bf16* proj = (const bf16*)FW(F, WS_PROJ);
    float* X = (float*)(F.lds);
    float* red = (float*)(F.lds + 65536);
    float* hid = (float*)(F.lds + 65536 + 8192);
    const int NU = 2 * BATCH * 128;
    for (int u = F.vcu; u < NU; u += F.G) {
        const int which = u / (BATCH * 128), b = (u / 128) % BATCH, n = u % 128;
        bf16* dst = (bf16*)FW(F, WS_SCR) + (size_t)which * (BATCH * 4 * 128 * 128);
        if (n == 127) { const int g = F.tid >> 7, e = F.tid & 127; dst[((size_t)(b * 4 + g) * 128 + n) * 128 + e] = 0; continue; }
        const float* pe = FIN(F, 4) + (size_t)(j * 2 + which) * 32 * 128;
        const float* w1 = FIN(F, 5) + (size_t)(j * 2 + which) * 4096 * 128;
        const float* w2 = FIN(F, 6) + (size_t)(j * 2 + which) * 128 * 128;
        const int col0 = which ? NSA_VC : NSA_KC;
        __syncthreads();
        for (int i = F.tid; i < 32 * 128 * 4; i += NTHREADS) { const int g = i & 3, d = (i >> 2) & 127, l = i >> 9;
            X[i] = bf2f(proj[(size_t)(b * SEQ + 16 * n + l) * NSA_NP + col0 + g * 128 + d]) + pe[l * 128 + d]; }
        __syncthreads();
        { const int e = F.tid & 127, ks = F.tid >> 7; float a0 = 0.f, a1 = 0.f, a2 = 0.f, a3 = 0.f;
          for (int l = ks * 8; l < ks * 8 + 8; ++l)
              for (int d = 0; d < 128; ++d) { const float w = w1[(size_t)(l * 128 + d) * 128 + e]; const v4f x = *(const v4f*)(X + (l * 128 + d) * 4); a0 += x.x * w; a1 += x.y * w; a2 += x.z * w; a3 += x.w * w; }
          red[(ks * 4 + 0) * 128 + e] = a0; red[(ks * 4 + 1) * 128 + e] = a1; red[(ks * 4 + 2) * 128 + e] = a2; red[(ks * 4 + 3) * 128 + e] = a3; }
        __syncthreads();
        { const int e = F.tid & 127, g = F.tid >> 7; const float s = red[(0 * 4 + g) * 128 + e] + red[(1 * 4 + g) * 128 + e] + red[(2 * 4 + g) * 128 + e] + red[(3 * 4 + g) * 128 + e]; hid[g * 128 + e] = gelu_tanh(s); }
        __syncthreads();
        { const int e2 = F.tid & 127, g = F.tid >> 7; float s = 0.f;
          for (int e = 0; e < 128; ++e) s += hid[g * 128 + e] * w2[e * 128 + e2];
          dst[((size_t)(b * 4 + g) * 128 + n) * 128 + e2] = (bf16)f2bf(s); }
    }
    __syncthreads();
}

__device__ __forceinline__ void attn_tile_naive(const float* qs, const bf16* Kb, const bf16* Vb, int ld, int lane, bool valid, float bias, float& m, float& l, float& o0, float& o1) {
    float s = 0.f;
    const v4u* kr = (const v4u*)(Kb + (size_t)lane * ld);
#pragma unroll 4
    for (int c = 0; c < 16; ++c) { const v4u w = kr[c]; const v4f qa = *(const v4f*)(qs + 8 * c), qb = *(const v4f*)(qs + 8 * c + 4);
        s += bflo(w.x) * qa.x + bfhi(w.x) * qa.y + bflo(w.y) * qa.z + bfhi(w.y) * qa.w + bflo(w.z) * qb.x + bfhi(w.z) * qb.y + bflo(w.w) * qb.z + bfhi(w.w) * qb.w; }
    s -= bias;
    const float tm = wave_max(valid ? s : -1e30f), mn = fmaxf(m, tm);
    const float p = valid ? __expf(s - mn) : 0.f, sc = __expf(m - mn);
    l = l * sc + wave_sum(p); o0 *= sc; o1 *= sc; m = mn;
#pragma unroll 8
    for (int k = 0; k < 64; ++k) { const float pk = __shfl(p, k); const unsigned vv = *(const unsigned*)(Vb + (size_t)k * ld + 2 * lane); o0 += pk * bflo(vv); o1 += pk * bfhi(vv); }
}

__device__ __forceinline__ void nsa_attn_naive(Frame& F) {
    const bf16* proj = (const bf16*)FW(F, WS_PROJ);
    const bf16* KC = (const bf16*)FW(F, WS_SCR); const bf16* VC = KC + (size_t)BATCH * 4 * 128 * 128;
    bf16* Y = (bf16*)FW(F, WS_Y);
    float* qsm = (float*)(F.lds);
    float* pc = (float*)(F.lds + 4096);
    float* pg = (float*)(F.lds + 8192);
    unsigned* msk = (unsigned*)(F.lds + 8192 + 512);
    const int jh = F.wave, lane = F.lane;
    const float scale = 0.08838834764831845f;
    for (int u = F.vcu; u < BATCH * 4 * SEQ; u += F.G) {
        const int t = u % SEQ, g = (u / SEQ) & 3, b = u / (4 * SEQ);
        const int h = g * 8 + jh; const float slope = exp2f(-8.0f * (float)(h + 1) / 32.0f);
        const size_t rowq = (size_t)(b * SEQ + t) * NSA_NP;
        float* qs = qsm + jh * 128;
        __syncthreads();
        { const unsigned w = *(const unsigned*)(proj + rowq + NSA_Q + h * 128 + 2 * lane); qs[2 * lane] = bflo(w) * scale; qs[2 * lane + 1] = bfhi(w) * scale; }
        __builtin_amdgcn_s_waitcnt(0xC07F); asm volatile("" ::: "memory");
        float oc0 = 0.f, oc1 = 0.f;
        {
            const bf16* kc = KC + (size_t)(b * 4 + g) * 128 * 128; const bf16* vc = VC + (size_t)(b * 4 + g) * 128 * 128;
            float s[2]; bool vd[2];
#pragma unroll
            for (int hh = 0; hh < 2; ++hh) { const int n = lane + 64 * hh; float a = 0.f; const v4u* kr = (const v4u*)(kc + (size_t)n * 128);
#pragma unroll 4
                for (int c = 0; c < 16; ++c) { const v4u w = kr[c]; const v4f qa = *(const v4f*)(qs + 8 * c), qb = *(const v4f*)(qs + 8 * c + 4);
                    a += bflo(w.x) * qa.x + bfhi(w.x) * qa.y + bflo(w.y) * qa.z + bfhi(w.y) * qa.w + bflo(w.z) * qb.x + bfhi(w.z) * qb.y + bflo(w.w) * qb.z + bfhi(w.w) * qb.w; }
                const int dist = t - (16 * n + 31); vd[hh] = (n < 127) && dist >= 0; s[hh] = a - slope * (float)dist; }
            const float mx = wave_max(fmaxf(vd[0] ? s[0] : -1e30f, vd[1] ? s[1] : -1e30f));
            float p0 = vd[0] ? __expf(s[0] - mx) : 0.f, p1 = vd[1] ? __expf(s[1] - mx) : 0.f;
            const float lsum = wave_sum(p0 + p1), inv = lsum > 0.f ? 1.0f / lsum : 0.f;
            p0 *= inv; p1 *= inv;
            pc[jh * 128 + lane] = p0; pc[jh * 128 + 64 + lane] = p1;
#pragma unroll 8
            for (int k = 0; k < 64; ++k) { const float pk = __shfl(p0, k); const unsigned vv = *(const unsigned*)(vc + (size_t)k * 128 + 2 * lane); oc0 += pk * bflo(vv); oc1 += pk * bfhi(vv); }
#pragma unroll 8
            for (int k = 0; k < 64; ++k) { const float pk = __shfl(p1, k); const unsigned vv = *(const unsigned*)(vc + (size_t)(k + 64) * 128 + 2 * lane); oc0 += pk * bflo(vv); oc1 += pk * bfhi(vv); }
        }
        __syncthreads();
        if (F.tid < 128) { float a = 0.f;
#pragma unroll
            for (int q = 0; q < 8; ++q) a += pc[q * 128 + F.tid];
            pg[F.tid] = (F.tid < 127) ? a : 0.f; }
        __syncthreads();
        const int cur = t >> 6;
        if (F.wave == 0) {
            float sc = -3e38f;
            if (lane < 32) { const int c0 = 4 * lane; float ps = 2.f * (pg[c0] + pg[c0 + 1] + pg[c0 + 2]) + pg[c0 + 3]; if (lane > 0) ps += pg[c0 - 1];
                sc = (lane == 0 || lane == cur || lane == cur - 1) ? 1e6f : (lane > cur ? -1.0f : ps); }
            unsigned mask = 0u; bool taken = false;
            for (int it = 0; it < 16; ++it) { const float v = taken ? -3e38f : sc; const float mx = wave_max(v);
                const unsigned long long bal = __ballot(v == mx && !taken && lane < 32); const int sel = __ffsll((long long)bal) - 1;
                mask |= 1u << sel; if (lane == sel) taken = true; }
            if (lane == 0) msk[0] = mask;
        }
        __syncthreads();
        const unsigned mask = msk[0];
        float ms = -1e30f, ls = 0.f, os0 = 0.f, os1 = 0.f;
        for (int kb = 0; kb <= cur; ++kb) { if (!((mask >> kb) & 1u)) continue;
            const int kp = kb * 64 + lane; const size_t r0 = (size_t)(b * SEQ + kb * 64) * NSA_NP;
            attn_tile_naive(qs, proj + r0 + NSA_KS + g * 128, proj + r0 + NSA_VS + g * 128, NSA_NP, lane, kp <= t, slope * (float)(t - kp), ms, ls, os0, os1); }
        float mw = -1e30f, lw = 0.f, ow0 = 0.f, ow1 = 0.f;
        { const int lo = t - 511 > 0 ? t - 511 : 0;
          for (int kb = lo >> 6; kb <= cur; ++kb) { const int kp = kb * 64 + lane; const size_t r0 = (size_t)(b * SEQ + kb * 64) * NSA_NP;
              attn_tile_naive(qs, proj + r0 + NSA_KW + g * 128, proj + r0 + NSA_VW + g * 128, NSA_NP, lane, kp <= t && kp >= lo, slope * (float)(t - kp), mw, lw, ow0, ow1); } }
        const float g0 = sigmoidf_(bf2f(proj[rowq + NSA_GL + 0 * 32 + h])), g1 = sigmoidf_(bf2f(proj[rowq + NSA_GL + 1 * 32 + h])), g2 = sigmoidf_(bf2f(proj[rowq + NSA_GL + 2 * 32 + h]));
        const float is = 1.0f / ls, iw = 1.0f / lw;
        const unsigned zw = *(const unsigned*)(proj + rowq + NSA_Z + h * 128 + 2 * lane);
        const float y0 = (g0 * oc0 + g1 * os0 * is + g2 * ow0 * iw) * siluf_(bflo(zw)), y1 = (g0 * oc1 + g1 * os1 * is + g2 * ow1 * iw) * siluf_(bfhi(zw));
        *(unsigned*)(Y + (size_t)(b * SEQ + t) * DM + h * 128 + 2 * lane) = pk2(y0, y1);
    }
    __syncthreads();
}

__device__ __forceinline__ void rg_gates_naive(Frame& F) {
    const bf16* proj = (const bf16*)FW(F, WS_PROJ);
    float* A = (float*)FW(F, WS_SCR); float* U = (float*)FW(F, WS_SCR + 128 * MiB);
    const float* conv_w = FIN(F, 9); const float* conv_b = FIN(F, 10); const float* gate_w = FIN(F, 11); const float* gate_b = FIN(F, 12); const float* lam = FIN(F, 13);
    float* xT = (float*)(F.lds);
    float* gt = (float*)(F.lds + 8192);
    const int NU = (MTOK / 8) * 16;
    for (int u = F.vcu; u < NU; u += F.G) {
        const int n = u & 15, tb = u >> 4, row0 = tb * 8;
        __syncthreads();
        for (int i = F.tid; i < 2048; i += NTHREADS) { const int c = i & 255, tk = i >> 8, ch = n * 256 + c, row = row0 + tk, tpos = row % SEQ;
            float a = conv_b[ch];
#pragma unroll
            for (int k4 = 0; k4 < 4; ++k4) { const int tp = tpos - 3 + k4; if (tp >= 0) a += conv_w[k4 * DM + ch] * bf2f(proj[(size_t)(row - 3 + k4) * RG_NP + ch]); }
            xT[c * 8 + tk] = a; }
        __syncthreads();
        { const int k = F.tid >> 8, e = F.tid & 255; float acc[8]; const float bb = gate_b[(k * 16 + n) * 256 + e];
#pragma unroll
          for (int q = 0; q < 8; ++q) acc[q] = bb;
          const float* wp = gate_w + ((size_t)(k * 16 + n) * 256) * 256 + e;
#pragma unroll 4
          for (int c = 0; c < 256; ++c) { const float w = wp[(size_t)c * 256]; const v4f x0 = *(const v4f*)(xT + c * 8), x1 = *(const v4f*)(xT + c * 8 + 4);
              acc[0] += x0.x * w; acc[1] += x0.y * w; acc[2] += x0.z * w; acc[3] += x0.w * w; acc[4] += x1.x * w; acc[5] += x1.y * w; acc[6] += x1.z * w; acc[7] += x1.w * w; }
#pragma unroll
          for (int q = 0; q < 8; ++q) gt[(k * 8 + q) * 256 + e] = sigmoidf_(acc[q]); }
        __syncthreads();
        for (int i = F.tid; i < 2048; i += NTHREADS) { const int c = i & 255, tk = i >> 8, ch = n * 256 + c, row = row0 + tk, tpos = row % SEQ;
            const float ig = gt[(0 * 8 + tk) * 256 + c], rg = gt[(1 * 8 + tk) * 256 + c];
            const float l = lam[ch]; const float sp = (-l > 20.f) ? -l : log1pf(expf(-l));
            const float log_a = -8.0f * rg * sp; const float a = expf(log_a);
            const float mult = tpos == 0 ? 1.0f : sqrtf(-expm1f(2.0f * log_a));
            A[(size_t)row * DM + ch] = a; U[(size_t)row * DM + ch] = mult * ig * xT[c * 8 + tk]; }
    }
    __syncthreads();
}
__device__ __forceinline__ void rg_scan(Frame& F) {
    const bf16* proj = (const bf16*)FW(F, WS_PROJ);
    const unsigned* AU = (const unsigned*)FW(F, WS_SCR);
    bf16* Y = (bf16*)FW(F, WS_Y);
    v2f* PP = (v2f*)(F.lds); v2f* HH = (v2f*)(F.lds + 4096);
    for (int u = F.vcu; u < BATCH * 64; u += F.G) {
        const int b = u >> 6, cp = F.tid & 31, ch = (u & 63) * 64 + 2 * cp, seg = F.tid >> 5;
        const size_t base = (size_t)(b * SEQ + seg * 128) * DM + ch;
        float P0 = 1.f, P1 = 1.f, H0 = 0.f, H1 = 0.f;
#pragma unroll 32
        for (int s = 0; s < 128; ++s) { const v2u w = *(const v2u*)(AU + base + (size_t)s * DM); const float a0 = 1.0f - bflo(w.x), a1 = 1.0f - bflo(w.y);
            H0 = a0 * H0 + bfhi(w.x); H1 = a1 * H1 + bfhi(w.y); P0 *= a0; P1 *= a1; }
        __syncthreads();
        PP[seg * 32 + cp] = (v2f){P0, P1}; HH[seg * 32 + cp] = (v2f){H0, H1};
        __syncthreads();
        float h0 = 0.f, h1 = 0.f;
        for (int s2 = 0; s2 < seg; ++s2) { const v2f p = PP[s2 * 32 + cp], hh = HH[s2 * 32 + cp]; h0 = p.x * h0 + hh.x; h1 = p.y * h1 + hh.y; }
        const size_t zb = (size_t)(b * SEQ + seg * 128) * RG_NP + 4096 + ch;
        for (int s0 = 0; s0 < 128; s0 += 32) {
            v2u wv[32]; unsigned zv[32];
#pragma unroll
            for (int i = 0; i < 32; ++i) { wv[i] = *(const v2u*)(AU + base + (size_t)(s0 + i) * DM); zv[i] = *(const unsigned*)(proj + zb + (size_t)(s0 + i) * RG_NP); }
#pragma unroll
            for (int i = 0; i < 32; ++i) { const v2u w = wv[i]; h0 = (1.0f - bflo(w.x)) * h0 + bfhi(w.x); h1 = (1.0f - bflo(w.y)) * h1 + bfhi(w.y);
                const unsigned z = zv[i]; *(unsigned*)(Y + base + (size_t)(s0 + i) * DM) = pk2(h0 * siluf_(bflo(z)), h1 * siluf_(bfhi(z))); }
        }
    }
    __syncthreads();
}

__device__ __forceinline__ void hg_naive(Frame& F) {
    const bf16* proj = (const bf16*)FW(F, WS_PROJ);
    const float* LB = (const float*)FW(F, WS_MISC + MISC_LB); const float* gain = FIN(F, 17);
    bf16* Y = (bf16*)FW(F, WS_Y);
    float* st = (float*)(F.lds);
    float* part = (float*)(F.lds + 8192);
    for (int u = F.vcu; u < BATCH * 32; u += F.G) {
        const int b = u >> 5, hd = u & 31, v = F.tid & 127, dg = F.tid >> 7;
        float S[32];
#pragma unroll
        for (int i = 0; i < 32; ++i) S[i] = 0.f;
        const float lb = (F.tid < 128) ? LB[hd * 128 + F.tid] : 0.f;
        const float gn = gain[v];
        __syncthreads();
        { const size_t r = (size_t)(b * SEQ) * HG_NP; float* s0 = st;
          if (F.tid < 128) { const float q = bf2f(proj[r + hd * 128 + F.tid]), fr = bf2f(proj[r + 4096 + hd * 128 + F.tid]); const float f = lb + (1.f - lb) * sigmoidf_(fr);
              s0[F.tid] = siluf_(q); s0[128 + F.tid] = f; s0[256 + F.tid] = 1.f - f; }
          else if (F.tid < 256) s0[384 + F.tid - 128] = bf2f(proj[r + 8192 + hd * 128 + F.tid - 128]);
          else if (F.tid < 384) s0[512 + F.tid - 256] = bf2f(proj[r + 12288 + hd * 128 + F.tid - 256]); }
        __syncthreads();
        for (int t = 0; t < SEQ; ++t) {
            float* sc = st + (t & 1) * 640; float* sn = st + ((t + 1) & 1) * 640;
            float r0 = 0.f, r1 = 0.f;
            if (t + 1 < SEQ) { const size_t r = (size_t)(b * SEQ + t + 1) * HG_NP;
                if (F.tid < 128) { r0 = bf2f(proj[r + hd * 128 + F.tid]); r1 = bf2f(proj[r + 4096 + hd * 128 + F.tid]); }
                else if (F.tid < 256) r0 = bf2f(proj[r + 8192 + hd * 128 + F.tid - 128]);
                else if (F.tid < 384) r0 = bf2f(proj[r + 12288 + hd * 128 + F.tid - 256]); }
            const float vv = sc[384 + v]; float p = 0.f;
#pragma unroll
            for (int i4 = 0; i4 < 8; ++i4) { const v4f qv = *(const v4f*)(sc + dg * 32 + 4 * i4), fv = *(const v4f*)(sc + 128 + dg * 32 + 4 * i4), kv = *(const v4f*)(sc + 256 + dg * 32 + 4 * i4);
                S[4 * i4 + 0] = fv.x * S[4 * i4 + 0] + kv.x * vv; p += qv.x * S[4 * i4 + 0];
                S[4 * i4 + 1] = fv.y * S[4 * i4 + 1] + kv.y * vv; p += qv.y * S[4 * i4 + 1];
                S[4 * i4 + 2] = fv.z * S[4 * i4 + 2] + kv.z * vv; p += qv.z * S[4 * i4 + 2];
                S[4 * i4 + 3] = fv.w * S[4 * i4 + 3] + kv.w * vv; p += qv.w * S[4 * i4 + 3]; }
            part[dg * 128 + v] = p;
            if (t + 1 < SEQ) {
                if (F.tid < 128) { const float f = lb + (1.f - lb) * sigmoidf_(r1); sn[F.tid] = siluf_(r0); sn[128 + F.tid] = f; sn[256 + F.tid] = 1.f - f; }
                else if (F.tid < 256) sn[384 + F.tid - 128] = r0;
                else if (F.tid < 384) sn[512 + F.tid - 256] = r0; }
            __syncthreads();
            if (F.wave == 0) { const int v0 = F.lane, v1 = F.lane + 64;
                const float o0 = part[v0] + part[128 + v0] + part[256 + v0] + part[384 + v0], o1 = part[v1] + part[128 + v1] + part[256 + v1] + part[384 + v1];
                const float rstd = rsqrtf(wave_sum(o0 * o0 + o1 * o1) * (1.f / 128.f) + NORM_EPS);
                const size_t yo = (size_t)(b * SEQ + t) * DM + hd * 128;
                Y[yo + v0] = (bf16)f2bf(o0 * rstd * gain[v0] * siluf_(sc[512 + v0])); Y[yo + v1] = (bf16)f2bf(o1 * rstd * gain[v1] * siluf_(sc[512 + v1])); }
            __syncthreads();
        }
        (void)gn;
    }
    __syncthreads();
}

namespace at {
using bf16x8 = __attribute__((ext_vector_type(8))) short;
using s16x4  = __attribute__((ext_vector_type(4))) short;
using f32x16 = __attribute__((ext_vector_type(16))) float;
using u32x4  = __attribute__((ext_vector_type(4))) unsigned;
constexpr int SHM_V = 64 * 128 * 2, SHM_K = 64 * 128 * 2;
#define KSWZ(row, colB) ((row) * 256 + ((colB) ^ (((row) & 7) << 4)))
#define SBAR() __builtin_amdgcn_sched_barrier(0)
__device__ __forceinline__ int crow(int r, int hi) { return (r & 3) + 8 * (r >> 2) + 4 * hi; }
__device__ __forceinline__ unsigned cvtpk(float lo, float hi) { unsigned r; asm volatile("v_cvt_pk_bf16_f32 %0, %1, %2" : "=v"(r) : "v"(lo), "v"(hi)); return r; }
__device__ __forceinline__ void qkt(f32x16& p0, f32x16& p1, const char* Ks, const bf16x8* qr, int r32, int hi) {
  p0 = f32x16{}; p1 = f32x16{};
#pragma unroll
  for (int d0 = 0; d0 < 8; ++d0) { int cb = (d0 * 16 + hi * 8) * 2;
    bf16x8 b0 = *reinterpret_cast<const bf16x8*>(Ks + KSWZ(r32, cb));
    bf16x8 b1 = *reinterpret_cast<const bf16x8*>(Ks + KSWZ(32 + r32, cb));
    p0 = __builtin_amdgcn_mfma_f32_32x32x16_bf16(b0, qr[d0], p0, 0, 0, 0);
    p1 = __builtin_amdgcn_mfma_f32_32x32x16_bf16(b1, qr[d0], p1, 0, 0, 0); }
}
__device__ __forceinline__ int v_st(int k, int c) { const int kk = (k & ~0xC) | ((k & 4) << 1) | ((k & 8) >> 1); return ((kk >> 3) * 4 + (c >> 5)) * 512 + ((kk & 7) * 32 + (c & 31)) * 2; }
__device__ __forceinline__ int v_rd_base(int lane) { return ((lane & 3) << 3) | (((lane >> 2) & 3) << 6) | (((lane >> 4) & 1) << 5) | (((lane >> 5) & 1) << 8); }
constexpr int v_rd_off(int d0, int ks, int half) { return d0 * 512 + ks * 4096 + half * 2048; }
template <int OFF> __device__ __forceinline__ s16x4 tr_read(int vb) {
  s16x4 r; asm volatile("ds_read_b64_tr_b16 %0, %1 offset:%2" : "=&v"(r) : "v"(vb), "i"(OFF) : "memory"); return r;
}
template <int D0> __device__ __forceinline__ void pv_one(f32x16& od, int vb, bf16x8 pa0, bf16x8 pa1, bf16x8 pa2, bf16x8 pa3) {
  const s16x4 l0 = tr_read<v_rd_off(D0, 0, 0)>(vb), h0 = tr_read<v_rd_off(D0, 0, 1)>(vb), l1 = tr_read<v_rd_off(D0, 1, 0)>(vb), h1 = tr_read<v_rd_off(D0, 1, 1)>(vb);
  const s16x4 l2 = tr_read<v_rd_off(D0, 2, 0)>(vb), h2 = tr_read<v_rd_off(D0, 2, 1)>(vb), l3 = tr_read<v_rd_off(D0, 3, 0)>(vb), h3 = tr_read<v_rd_off(D0, 3, 1)>(vb);
  asm volatile("s_waitcnt lgkmcnt(0)" ::: "memory"); SBAR();
#define PK(L, H) (bf16x8){L[0], L[1], L[2], L[3], H[0], H[1], H[2], H[3]}
  od = __builtin_amdgcn_mfma_f32_32x32x16_bf16(pa0, PK(l0, h0), od, 0, 0, 0);
  od = __builtin_amdgcn_mfma_f32_32x32x16_bf16(pa1, PK(l1, h1), od, 0, 0, 0);
  od = __builtin_amdgcn_mfma_f32_32x32x16_bf16(pa2, PK(l2, h2), od, 0, 0, 0);
  od = __builtin_amdgcn_mfma_f32_32x32x16_bf16(pa3, PK(l3, h3), od, 0, 0, 0);
#undef PK
}
#define PV_RD(D0, L0, H0, L1, H1, L2, H2, L3, H3) do { L0 = tr_read<v_rd_off(D0, 0, 0)>(vb); H0 = tr_read<v_rd_off(D0, 0, 1)>(vb); L1 = tr_read<v_rd_off(D0, 1, 0)>(vb); H1 = tr_read<v_rd_off(D0, 1, 1)>(vb); \
    L2 = tr_read<v_rd_off(D0, 2, 0)>(vb); H2 = tr_read<v_rd_off(D0, 2, 1)>(vb); L3 = tr_read<v_rd_off(D0, 3, 0)>(vb); H3 = tr_read<v_rd_off(D0, 3, 1)>(vb); } while (0)
#define PV_PK(L, H) (bf16x8){L[0], L[1], L[2], L[3], H[0], H[1], H[2], H[3]}
#define PV_MM(OD, L0, H0, L1, H1, L2, H2, L3, H3) do { OD = __builtin_amdgcn_mfma_f32_32x32x16_bf16(pa0, PV_PK(L0, H0), OD, 0, 0, 0); OD = __builtin_amdgcn_mfma_f32_32x32x16_bf16(pa1, PV_PK(L1, H1), OD, 0, 0, 0); \
    OD = __builtin_amdgcn_mfma_f32_32x32x16_bf16(pa2, PV_PK(L2, H2), OD, 0, 0, 0); OD = __builtin_amdgcn_mfma_f32_32x32x16_bf16(pa3, PV_PK(L3, H3), OD, 0, 0, 0); } while (0)
__device__ __forceinline__ void pv_d0(f32x16* o, int vb, bf16x8 pa0, bf16x8 pa1, bf16x8 pa2, bf16x8 pa3) {
  s16x4 al0, ah0, al1, ah1, al2, ah2, al3, ah3, bl0, bh0, bl1, bh1, bl2, bh2, bl3, bh3;
  PV_RD(0, al0, ah0, al1, ah1, al2, ah2, al3, ah3);
  PV_RD(1, bl0, bh0, bl1, bh1, bl2, bh2, bl3, bh3);
  asm volatile("s_waitcnt lgkmcnt(8)" ::: "memory"); SBAR();
  PV_MM(o[0], al0, ah0, al1, ah1, al2, ah2, al3, ah3); SBAR();
  PV_RD(2, al0, ah0, al1, ah1, al2, ah2, al3, ah3);
  asm volatile("s_waitcnt lgkmcnt(8)" ::: "memory"); SBAR();
  PV_MM(o[1], bl0, bh0, bl1, bh1, bl2, bh2, bl3, bh3); SBAR();
  PV_RD(3, bl0, bh0, bl1, bh1, bl2, bh2, bl3, bh3);
  asm volatile("s_waitcnt lgkmcnt(8)" ::: "memory"); SBAR();
  PV_MM(o[2], al0, ah0, al1, ah1, al2, ah2, al3, ah3); SBAR();
  asm volatile("s_waitcnt lgkmcnt(0)" ::: "memory"); SBAR();
  PV_MM(o[3], bl0, bh0, bl1, bh1, bl2, bh2, bl3, bh3);
}
template <int CTRL> __device__ __forceinline__ float dppx(float x) { return __builtin_bit_cast(float, __builtin_amdgcn_mov_dpp(__builtin_bit_cast(int, x), CTRL, 0xf, 0xf, true)); }
__device__ __forceinline__ float swapmax(float x) { auto rr = __builtin_amdgcn_permlane32_swap(__float_as_uint(x), __float_as_uint(x), false, false); return fmaxf(__uint_as_float(rr[0]), __uint_as_float(rr[1])); }
__device__ __forceinline__ float swapsum(float x) { auto rr = __builtin_amdgcn_permlane32_swap(__float_as_uint(x), __float_as_uint(x), false, false); return __uint_as_float(rr[0]) + __uint_as_float(rr[1]); }
#define PK4(P, BASE, OUT) do { unsigned a0 = cvtpk(P[BASE + 0], P[BASE + 1]), a1 = cvtpk(P[BASE + 2], P[BASE + 3]);   \
    unsigned b0 = cvtpk(P[BASE + 4], P[BASE + 5]), b1 = cvtpk(P[BASE + 6], P[BASE + 7]);                              \
    auto r0 = __builtin_amdgcn_permlane32_swap(a0, b0, false, false); auto r1 = __builtin_amdgcn_permlane32_swap(a1, b1, false, false); \
    u32x4 w = {r0[0], r1[0], r0[1], r1[1]}; OUT = *reinterpret_cast<bf16x8*>(&w); } while (0)

constexpr float LOG2E = 1.4426950408889634f;
constexpr float CSC = 0.088388347648318440f * LOG2E;
constexpr float THR2 = 8.0f * LOG2E;

__device__ __forceinline__ void score_xform(f32x16& p0, f32x16& p1, float sl, float base, bool mask, int kp0, int t, int tlo) {
  const float s2_ = sl + sl, s4_ = s2_ + s2_, s8_ = s4_ + s4_;
  const float a_[4] = {0.f, sl, s2_, s2_ + sl};
  float b_[8]; b_[0] = base;
#pragma unroll
  for (int q = 1; q < 8; ++q) b_[q] = b_[q - 1] + s8_;
#pragma unroll
  for (int r = 0; r < 16; ++r) { p0[r] = fmaf(p0[r], CSC, a_[r & 3] + b_[r >> 2]); p1[r] = fmaf(p1[r], CSC, a_[r & 3] + b_[4 + (r >> 2)]); }
  if (mask) {
    const int dhi = t - kp0, dlo = tlo - kp0;
#pragma unroll
    for (int r = 0; r < 16; ++r) { const int c = (r & 3) + 8 * (r >> 2);
      p0[r] = (c > dhi || c < dlo) ? -1e30f : p0[r]; p1[r] = (c + 32 > dhi || c + 32 < dlo) ? -1e30f : p1[r]; } }
}
__device__ __forceinline__ void softmax_step(f32x16& p0, f32x16& p1, float& m, float& l, float& alpha, bf16x8& pa0, bf16x8& pa1, bf16x8& pa2, bf16x8& pa3) {
  float pmax = p0[0];
#pragma unroll
  for (int r = 1; r < 16; ++r) pmax = fmaxf(pmax, p0[r]);
#pragma unroll
  for (int r = 0; r < 16; ++r) pmax = fmaxf(pmax, p1[r]);
  pmax = swapmax(pmax);
  if (__all(pmax - m <= THR2)) { alpha = 1.f; }
  else { const float mn = fmaxf(m, pmax); alpha = __builtin_amdgcn_exp2f(m - mn); m = mn; }
  float ps = 0.f;
#pragma unroll
  for (int r = 0; r < 16; ++r) { p0[r] = __builtin_amdgcn_exp2f(p0[r] - m); ps += p0[r]; }
#pragma unroll
  for (int r = 0; r < 16; ++r) { p1[r] = __builtin_amdgcn_exp2f(p1[r] - m); ps += p1[r]; }
  ps = swapsum(ps);
  l = l * alpha + ps;
  PK4(p0, 0, pa0); PK4(p0, 8, pa1); PK4(p1, 0, pa2); PK4(p1, 8, pa3);
}
}

constexpr int AT_K = 0  , AT_V = 32768  , AT_OT = 81920  , AT_WS = 147456  , AT_SC = AT_WS + 2048  , AT_MK = AT_SC + 4096  ;
static_assert(AT_MK + 256 <= MISC_OFF, "attention LDS map below the barrier words");

template <int VAR>
__device__ __forceinline__ void nsa_attn_mfma(Frame& F, bf16* Y) {
  using namespace at;
  const bf16* proj = (const bf16*)FW(F, WS_PROJ);
  const bf16* KC = (const bf16*)FW(F, WS_SCR); const bf16* VC = KC + (size_t)BATCH * 4 * 128 * 128;
  unsigned char* lds = F.lds;
  char* V_lds = (char*)lds + AT_V; char* K_lds = (char*)lds + AT_K;
  const int tid = F.tid, wid = F.wave;
  float* wsf = (float*)(lds + AT_WS) + wid * 64;
  float* scl = (float*)(lds + AT_SC); unsigned* mkl = (unsigned*)(lds + AT_MK);

#define TDMA(Kp, Vp, ldE, kbuf_, vbuf_) do { \
    LAS unsigned char* kd_ = (LAS unsigned char*)lds + AT_K + (kbuf_) * SHM_K + wid * 1024; LAS unsigned char* vd_ = (LAS unsigned char*)lds + AT_V + (vbuf_) * SHM_V + wid * 1024; \
    __builtin_amdgcn_global_load_lds((const unsigned*)(Kp), (LAS unsigned*)kd_, 16, 0, 0); __builtin_amdgcn_global_load_lds((const unsigned*)((Kp) + (size_t)32 * (ldE)), (LAS unsigned*)(kd_ + 8192), 16, 0, 0); \
    __builtin_amdgcn_global_load_lds((const unsigned*)(Vp), (LAS unsigned*)vd_, 16, 0, 0); __builtin_amdgcn_global_load_lds((const unsigned*)((Vp) + (size_t)32 * (ldE)), (LAS unsigned*)(vd_ + 8192), 16, 0, 0); } while (0)
#define TWAIT() do { asm volatile("s_waitcnt vmcnt(0)" ::: "memory"); __syncthreads(); } while (0)
#define RESC(a) do { if (__any((a) < 1.f)) { if (hi == 0) al_l[r32] = (a); asm volatile("s_waitcnt lgkmcnt(0)" ::: "memory"); \
    _Pragma("unroll") for (int d = 0; d < 4; ++d) _Pragma("unroll") for (int r = 0; r < 16; ++r) o[d][r] *= al_l[crow(r, hi)]; asm volatile("s_waitcnt lgkmcnt(0)" ::: "memory"); } } while (0)
#define FOLD(fval, FIRST) do { if (hi == 0) li_l[r32] = (fval); asm volatile("s_waitcnt lgkmcnt(0)" ::: "memory"); \
    _Pragma("unroll") for (int r = 0; r < 16; r += 2) { const float fa_ = li_l[crow(r, hi)], fb_ = li_l[crow(r + 1, hi)]; \
      v4u w_; if (!(FIRST)) w_ = otl[(r >> 1) * 512]; else { w_.x = 0u; w_.y = 0u; w_.z = 0u; w_.w = 0u; } \
      w_.x = cvtpk(bflo(w_.x) + o[0][r] * fa_, bfhi(w_.x) + o[0][r + 1] * fb_); w_.y = cvtpk(bflo(w_.y) + o[1][r] * fa_, bfhi(w_.y) + o[1][r + 1] * fb_); \
      w_.z = cvtpk(bflo(w_.z) + o[2][r] * fa_, bfhi(w_.z) + o[2][r + 1] * fb_); w_.w = cvtpk(bflo(w_.w) + o[3][r] * fa_, bfhi(w_.w) + o[3][r + 1] * fb_); \
      otl[(r >> 1) * 512] = w_; } \
    asm volatile("s_waitcnt lgkmcnt(0)" ::: "memory"); } while (0)
#define FOLDL(fval) do { if (hi == 0) li_l[r32] = (fval); asm volatile("s_waitcnt lgkmcnt(0)" ::: "memory"); \
    _Pragma("unroll") for (int r = 0; r < 16; r += 2) { const float fa_ = li_l[crow(r, hi)], fb_ = li_l[crow(r + 1, hi)]; \
      v4u w_ = otl[(r >> 1) * 512]; \
      w_.x = cvtpk(bflo(w_.x) + o[0][r] * fa_, bfhi(w_.x) + o[0][r + 1] * fb_); w_.y = cvtpk(bflo(w_.y) + o[1][r] * fa_, bfhi(w_.y) + o[1][r + 1] * fb_); \
      w_.z = cvtpk(bflo(w_.z) + o[2][r] * fa_, bfhi(w_.z) + o[2][r + 1] * fb_); w_.w = cvtpk(bflo(w_.w) + o[3][r] * fa_, bfhi(w_.w) + o[3][r + 1] * fb_); \
      unsigned short* ra_ = rowst + ((r & 3) + 8 * (r >> 2)) * ROWP; unsigned short* rb_ = ra_ + ROWP; \
      ra_[0] = (unsigned short)w_.x; rb_[0] = (unsigned short)(w_.x >> 16); ra_[32] = (unsigned short)w_.y; rb_[32] = (unsigned short)(w_.y >> 16); \
      ra_[64] = (unsigned short)w_.z; rb_[64] = (unsigned short)(w_.z >> 16); ra_[96] = (unsigned short)w_.w; rb_[96] = (unsigned short)(w_.w >> 16); } \
    asm volatile("s_waitcnt lgkmcnt(0)" ::: "memory"); } while (0)

  for (int uu = F.vcu * 4; uu < 1024; uu += (uu % 4 == 3) ? (F.G - 1) * 4 + 1 : 1) {
    const int ui = uu & 3;
    int lane = F.lane; asm volatile("" : "+v"(lane));
    const int r32 = lane & 31, hi = lane >> 5, tsub = r32 >> 3, j = r32 & 7, tl_ = wid * 64 + lane;
    const int krow = tl_ >> 4, kcol = ((lane & 15) ^ (krow & 7)) * 8;
    const int vkk = (wid >> 1) * 8 + ((lane >> 2) & 7), vrow = (vkk & ~0xC) | ((vkk & 4) << 1) | ((vkk & 8) >> 1), vcol = ((wid & 1) * 2 + (lane >> 5)) * 32 + (lane & 3) * 8;
    const int vb0 = (int)(uintptr_t)((LAS unsigned char*)lds + AT_V) + v_rd_base(lane);
    float* li_l = wsf; float* al_l = wsf + 32;
    v4u* otl = (v4u*)(lds + AT_OT) + tl_;
    constexpr int ROWP = 136;
    unsigned short* rowst = (unsigned short*)(lds + AT_K) + (wid * 32 + 4 * hi) * ROWP + r32;
    const int wg = uu >> 2, b = wg >> 6, kq_ = wg & 63, k32_ = (kq_ + 32) & 63;
    const int g = ui, qb = (ui == 0) ? kq_ : (ui == 1) ? 63 - kq_ : (ui == 2) ? k32_ : 63 - k32_;
    const int t0 = qb * 32, cur = t0 >> 6;
    const int t = t0 + 4 * wid + tsub, h = g * 8 + j;
    const float slope2 = exp2f(-0.25f * (float)(h + 1)) * LOG2E;
    const size_t rowq = (size_t)(b * SEQ + t) * NSA_NP;
    bf16x8 qr[8];
#pragma unroll
    for (int d0 = 0; d0 < 8; ++d0) qr[d0] = *(const bf16x8*)(proj + rowq + NSA_Q + h * 128 + d0 * 16 + hi * 8);
    const float g0 = sigmoidf_(bf2f(proj[rowq + NSA_GL + 0 * 32 + h])), g1 = sigmoidf_(bf2f(proj[rowq + NSA_GL + 1 * 32 + h])), g2 = sigmoidf_(bf2f(proj[rowq + NSA_GL + 2 * 32 + h]));
    f32x16 o[4];
#pragma unroll
    for (int d = 0; d < 4; ++d) { o[d] = f32x16{}; }
    __syncthreads();

    {
      const bf16* kc = KC + (size_t)(b * 4 + g) * 128 * 128; const bf16* vc = VC + (size_t)(b * 4 + g) * 128 * 128;
      { const bf16* kcp = kc + krow * 128 + kcol; const bf16* vcp = vc + vrow * 128 + vcol; TDMA(kcp, vcp, 128, 0, 0); if (cur > 15) TDMA(kcp + 64 * 128, vcp + 64 * 128, 128, 1, 1); }
      TWAIT();
      f32x16 pA0, pA1, pB0, pB1;
      qkt(pA0, pA1, K_lds, qr, r32, hi); if (cur > 15) qkt(pB0, pB1, K_lds + SHM_K, qr, r32, hi); else { pB0 = f32x16{}; pB1 = f32x16{}; }
      __syncthreads();
      if (VAR < 5) TDMA(proj + (size_t)(b * SEQ + cur * 64 + krow) * NSA_NP + NSA_KS + g * 128 + kcol, proj + (size_t)(b * SEQ + cur * 64 + vrow) * NSA_NP + NSA_VS + g * 128 + vcol, NSA_NP, 0, 2);
      const float sl16 = 16.f * slope2, s32_ = sl16 + sl16, s64_ = s32_ + s32_, s128_ = s64_ + s64_;
      const float baseA = slope2 * (float)(16 * (4 * hi) + 31 - t);
      const float ca_[4] = {0.f, sl16, s32_, s32_ + sl16};
      float cb_[16]; cb_[0] = baseA;
#pragma unroll
      for (int q = 1; q < 16; ++q) cb_[q] = cb_[q - 1] + s128_;
      float mx = -1e30f;
      const int nlim = ((t - 31) >> 4) - 4 * hi;
#pragma unroll
      for (int r = 0; r < 16; ++r) { const int c = (r & 3) + 8 * (r >> 2);
        float a0 = fmaf(pA0[r], CSC, ca_[r & 3] + cb_[r >> 2]), a1 = fmaf(pA1[r], CSC, ca_[r & 3] + cb_[4 + (r >> 2)]);
        float b0 = fmaf(pB0[r], CSC, ca_[r & 3] + cb_[8 + (r >> 2)]), b1 = fmaf(pB1[r], CSC, ca_[r & 3] + cb_[12 + (r >> 2)]);
        a0 = (c > nlim) ? -1e30f : a0; a1 = (c + 32 > nlim) ? -1e30f : a1;
        b0 = (c + 64 > nlim) ? -1e30f : b0; b1 = (c + 96 > nlim || (c == 27 && hi)) ? -1e30f : b1;
        pA0[r] = a0; pA1[r] = a1; pB0[r] = b0; pB1[r] = b1; mx = fmaxf(fmaxf(mx, fmaxf(a0, a1)), fmaxf(b0, b1)); }
      mx = swapmax(mx);
      float ps = 0.f;
#pragma unroll
      for (int r = 0; r < 16; ++r) { pA0[r] = __builtin_amdgcn_exp2f(pA0[r] - mx); pA1[r] = __builtin_amdgcn_exp2f(pA1[r] - mx); pB0[r] = __builtin_amdgcn_exp2f(pB0[r] - mx); pB1[r] = __builtin_amdgcn_exp2f(pB1[r] - mx);
        ps += (pA0[r] + pA1[r]) + (pB0[r] + pB1[r]); }
      ps = swapsum(ps);
      const float anyv = (t >= 31) ? 1.f : 0.f; const float inv = anyv / ps;
      bf16x8 pa0, pa1, pa2, pa3;
      bf16x8 pa4, pa5, pa6, pa7;
      PK4(pA0, 0, pa0); PK4(pA0, 8, pa1); PK4(pA1, 0, pa2); PK4(pA1, 8, pa3);
      PK4(pB0, 0, pa4); PK4(pB0, 8, pa5); PK4(pB1, 0, pa6); PK4(pB1, 8, pa7);
      SBAR();
      if (cur <= 15) {
        if (lane == 0) { mkl[4 * wid + 0] = 0xffffffffu; mkl[4 * wid + 1] = 0xffffffffu; mkl[4 * wid + 2] = 0xffffffffu; mkl[4 * wid + 3] = 0xffffffffu; }
      } else {
#pragma unroll
      for (int r = 0; r < 16; ++r) {
        float a0 = pA0[r] * inv, a1 = pA1[r] * inv, b0 = pB0[r] * inv, b1 = pB1[r] * inv;
        a0 += dppx<0xB1>(a0); a1 += dppx<0xB1>(a1); b0 += dppx<0xB1>(b0); b1 += dppx<0xB1>(b1);
        a0 += dppx<0x4E>(a0); a1 += dppx<0x4E>(a1); b0 += dppx<0x4E>(b0); b1 += dppx<0x4E>(b1);
        a0 += dppx<0x141>(a0); a1 += dppx<0x141>(a1); b0 += dppx<0x141>(b0); b1 += dppx<0x141>(b1);
        pA0[r] = a0; pA1[r] = a1; pB0[r] = b0; pB1[r] = b1; }
      float slc[16];
#pragma unroll
      for (int T = 0; T < 4; ++T)
#pragma unroll
        for (int q = 0; q < 4; ++q) {
          const f32x16& P = (T == 0) ? pA0 : (T == 1) ? pA1 : (T == 2) ? pB0 : pB1;
          slc[T * 4 + q] = 2.f * (P[4 * q] + P[4 * q + 1] + P[4 * q + 2]) + P[4 * q + 3];
          float a;
          if (q > 0) a = P[4 * (q - 1) + 3];
          else if (T > 0) { const f32x16& Pm = (T == 1) ? pA0 : (T == 2) ? pA1 : pB0; a = Pm[15]; }
          else a = 0.f;
          const float give = hi ? a : P[4 * q + 3];
          { auto rr_ = __builtin_amdgcn_permlane32_swap(__float_as_uint(give), __float_as_uint(give), false, false); slc[T * 4 + q] += __uint_as_float(hi ? rr_[0] : rr_[1]); } }
      if (j == 0) {
#pragma unroll
        for (int T = 0; T < 4; ++T)
#pragma unroll
          for (int q = 0; q < 4; ++q) { const int blk = 8 * T + 2 * q + hi;
            const float s = (blk == 0 || blk == cur || blk == cur - 1) ? 1e6f : (blk > cur ? -1.0f : slc[T * 4 + q]);
            scl[(4 * wid + tsub) * 32 + blk] = s; }
      }
      asm volatile("s_waitcnt lgkmcnt(0)" ::: "memory");
#pragma unroll
      for (int pss = 0; pss < 2; ++pss) {
        const int tl = 4 * wid + 2 * pss + hi, blk = r32; const float* row = scl + tl * 32; const float mys = row[blk]; int rank = 0;
#pragma unroll
        for (int q4 = 0; q4 < 8; ++q4) { const v4f v = *(const v4f*)(row + 4 * q4);
          rank += (v.x > mys || (v.x == mys && 4 * q4 + 0 < blk)) ? 1 : 0; rank += (v.y > mys || (v.y == mys && 4 * q4 + 1 < blk)) ? 1 : 0;
          rank += (v.z > mys || (v.z == mys && 4 * q4 + 2 < blk)) ? 1 : 0; rank += (v.w > mys || (v.w == mys && 4 * q4 + 3 < blk)) ? 1 : 0; }
        const unsigned long long bal = __ballot(rank < 16);
        if (lane == 0) { mkl[4 * wid + 2 * pss] = (unsigned)bal; mkl[4 * wid + 2 * pss + 1] = (unsigned)(bal >> 32); }
      }
      }
      SBAR();
      pv_d0(o, vb0, pa0, pa1, pa2, pa3);
      if (cur > 15) pv_d0(o, vb0 + SHM_V, pa4, pa5, pa6, pa7);
      SBAR();
      FOLD(g0 * inv, true);
    }
    __syncthreads();
    unsigned anymask = 0u;
#pragma unroll
    for (int i = 0; i < 32; ++i) anymask |= mkl[i];
    anymask = __builtin_amdgcn_readfirstlane(anymask);
    const unsigned mymask = mkl[4 * wid + tsub];

    int it = 0, vbuf = 2;
#pragma unroll
    for (int br = 0; br < 2; ++br) {
      const bf16* Kg = proj + (size_t)(b * SEQ) * NSA_NP + (br == 0 ? NSA_KS : NSA_KW) + g * 128;
      const bf16* Vg = proj + (size_t)(b * SEQ) * NSA_NP + (br == 0 ? NSA_VS : NSA_VW) + g * 128;
      const int wlo = t0 + 31 - 511;
      const int kb_lo = (br == 0) ? 0 : ((t0 - 511 > 0 ? t0 - 511 : 0) >> 6);
      unsigned tiles = (br == 0) ? (anymask & (cur == 31 ? 0xffffffffu : ((2u << cur) - 1u))) : ((cur == 31 ? 0xffffffffu : ((2u << cur) - 1u)) & ~((1u << kb_lo) - 1u));
      const int tlo = (br == 0) ? 0 : (t - 511 > 0 ? t - 511 : 0);
      float m = -1e30f, l = 0.f;
#pragma unroll
      for (int d = 0; d < 4; ++d) o[d] = f32x16{};
      const bf16* kgp = Kg + (size_t)krow * NSA_NP + kcol; const bf16* vgp = Vg + (size_t)vrow * NSA_NP + vcol;
      int kb = 31 - __builtin_clz(tiles); tiles &= ~(1u << kb);
#define TILE_SM(KB, PA0, PA1, PA2, PA3, AL) do { const int kp0_ = (KB) * 64 + 4 * hi; const float rowbias_ = (br == 0 && !((mymask >> (KB)) & 1u)) ? -1e30f : 0.f; \
        const bool need_mask_ = ((KB) == cur) || (br == 1 && (KB) * 64 < wlo); \
        if (VAR == 1 || VAR == 2) { AL = 1.f; l += rowbias_ + (need_mask_ ? 1.f : 2.f); _Pragma("unroll") for (int r = 0; r < 16; ++r) { p0[r] = __builtin_fmaxf(p0[r], -3.0e38f); p1[r] = __builtin_fmaxf(p1[r], -3.0e38f); } \
          PK4(p0, 0, PA0); PK4(p0, 8, PA1); PK4(p1, 0, PA2); PK4(p1, 8, PA3); } else { \
        score_xform(p0, p1, slope2, slope2 * (float)(kp0_ - t) + rowbias_, need_mask_, kp0_, t, tlo); \
        softmax_step(p0, p1, m, l, AL, PA0, PA1, PA2, PA3); } } while (0)
      if (VAR < 5) for (;;) {
        const int kbuf = it & 1;
        TWAIT();
        const int kbn = tiles ? 31 - __builtin_clz(tiles) : -1; const int vbn = (vbuf == 2) ? 0 : vbuf + 1;
        if (kbn >= 0) { tiles &= ~(1u << kbn); TDMA(kgp + (size_t)kbn * 64 * NSA_NP, vgp + (size_t)kbn * 64 * NSA_NP, NSA_NP, kbuf ^ 1, vbn); }
        else if (br == 0) TDMA(kgp + (size_t)cur * 64 * NSA_NP + (NSA_KW - NSA_KS), vgp + (size_t)cur * 64 * NSA_NP + (NSA_VW - NSA_VS), NSA_NP, kbuf ^ 1, vbn);
        if (VAR != 4) { f32x16 p0, p1; if (VAR != 3) qkt(p0, p1, K_lds + kbuf * SHM_K, qr, r32, hi); else { p0 = o[0]; p1 = o[1]; }
          float alpha_; bf16x8 pa0_, pa1_, pa2_, pa3_; TILE_SM(kb, pa0_, pa1_, pa2_, pa3_, alpha_); RESC(alpha_);
          if (VAR != 2) pv_d0(o, vb0 + vbuf * SHM_V, pa0_, pa1_, pa2_, pa3_); else { o[0][0] += __builtin_bit_cast(float, pa0_[0] | (pa1_[1] << 16)) + __builtin_bit_cast(float, pa2_[0] | (pa3_[1] << 16)); } }
        if (kbn < 0) break;
        kb = kbn; ++it; vbuf = vbn;
      }
      ++it; vbuf = (vbuf == 2) ? 0 : vbuf + 1;
#undef TILE_SM
      if (br == 0) { FOLD(g1 / l, false); __syncthreads(); }
      else { __syncthreads(); FOLDL(g2 / l); }
    }

    if (VAR != 6) {
      v4u zv[8];
#pragma unroll
      for (int j = 0; j < 8; ++j) { const int row = 4 * j + (lane >> 4), tt = t0 + 4 * wid + (row >> 3), hh = g * 8 + (row & 7);
        zv[j] = *(const v4u*)(proj + (size_t)(b * SEQ + tt) * NSA_NP + NSA_Z + hh * 128 + (lane & 15) * 8); }
#pragma unroll
      for (int j = 0; j < 8; ++j) { const int row = 4 * j + (lane >> 4), tt = t0 + 4 * wid + (row >> 3), hh = g * 8 + (row & 7);
        const v4u tv = *(const v4u*)((const unsigned short*)(lds + AT_K) + (wid * 32 + row) * ROWP + (lane & 15) * 8); const v4u z = zv[j]; v4u y;
        y.x = cvtpk(bflo(tv.x) * siluf_(bflo(z.x)), bfhi(tv.x) * siluf_(bfhi(z.x))); y.y = cvtpk(bflo(tv.y) * siluf_(bflo(z.y)), bfhi(tv.y) * siluf_(bfhi(z.y)));
        y.z = cvtpk(bflo(tv.z) * siluf_(bflo(z.z)), bfhi(tv.z) * siluf_(bfhi(z.z))); y.w = cvtpk(bflo(tv.w) * siluf_(bflo(z.w)), bfhi(tv.w) * siluf_(bfhi(z.w)));
        *(v4u*)(Y + (size_t)(b * SEQ + tt) * DM + hh * 128 + (lane & 15) * 8) = y; }
    }
  }
  __syncthreads();
#undef TDMA
#undef TWAIT
#undef RESC
#undef FOLD
#undef FOLDL
}

__device__ __forceinline__ void rg_conv(Frame& F) {
    const bf16* proj = (const bf16*)FW(F, WS_PROJ); bf16* XC = (bf16*)FW(F, WS_Y);
    const float* conv_w = FIN(F, 9); const float* conv_b = FIN(F, 10);
    constexpr int CR = 16;
    for (int it = F.vcu * NTHREADS + F.tid; it < (MTOK / CR) * 512; it += F.G * NTHREADS) {
        const int row0 = (it >> 9) * CR, ch = (it & 511) * 8; const bool head = (row0 & (SEQ - 1)) == 0;
        v4u x[CR + 3];
#pragma unroll
        for (int i = 0; i < CR + 3; ++i) x[i] = *(const v4u*)(proj + (size_t)((i < 3 && head) ? row0 : row0 - 3 + i) * RG_NP + ch);
        v4f w0[4], w1[4];
#pragma unroll
        for (int k4 = 0; k4 < 4; ++k4) { w0[k4] = *(const v4f*)(conv_w + k4 * DM + ch); w1[k4] = *(const v4f*)(conv_w + k4 * DM + ch + 4); }
        const v4f b0 = *(const v4f*)(conv_b + ch), b1 = *(const v4f*)(conv_b + ch + 4);
#pragma unroll
        for (int i = 0; i < 3; ++i) { x[i].x = head ? 0u : x[i].x; x[i].y = head ? 0u : x[i].y; x[i].z = head ? 0u : x[i].z; x[i].w = head ? 0u : x[i].w; }
#pragma unroll
        for (int j = 0; j < CR; ++j) { v4f a0 = b0, a1 = b1;
#pragma unroll
            for (int k4 = 0; k4 < 4; ++k4) { const v4u xx = x[j + k4];
                a0.x += w0[k4].x * bflo(xx.x); a0.y += w0[k4].y * bfhi(xx.x); a0.z += w0[k4].z * bflo(xx.y); a0.w += w0[k4].w * bfhi(xx.y);
                a1.x += w1[k4].x * bflo(xx.z); a1.y += w1[k4].y * bfhi(xx.z); a1.z += w1[k4].z * bflo(xx.w); a1.w += w1[k4].w * bfhi(xx.w); }
            v4u o; o.x = pk2(a0.x, a0.y); o.y = pk2(a0.z, a0.w); o.z = pk2(a1.x, a1.y); o.w = pk2(a1.z, a1.w);
            *(v4u*)(XC + (size_t)(row0 + j) * DM + ch) = o; }
    }
}
struct EpiRG {
    static constexpr bool PERM = false, AFTER_DRAIN = false;
    const bf16* XC; const float* gate_b; const float* SP; unsigned* AU;
    __device__ __forceinline__ void operator()(const pg8::f32x4 (&acc)[2][2][4][2], const pg8::Unit& u, int wr, int wc, int fr, int fq) const {
        asm volatile("" : "+v"(fr), "+v"(fq));
        const int row0 = u.pm * 256 + wr * 64 + fr, ch0 = u.pn * 128 + wc * 32 + 4 * fq;
        v4f biv[2], brv[2], spv[2];
        v2u xv[2][2][4];
#pragma unroll
        for (int n = 0; n < 2; ++n)
#pragma unroll
            for (int ai = 0; ai < 2; ++ai)
#pragma unroll
                for (int m = 0; m < 4; ++m) xv[n][ai][m] = *(const v2u*)(XC + (size_t)(row0 + ai * 128 + m * 16) * DM + ch0 + 16 * n);
#pragma unroll
        for (int n = 0; n < 2; ++n) { biv[n] = *(const v4f*)(gate_b + ch0 + 16 * n); brv[n] = *(const v4f*)(gate_b + DM + ch0 + 16 * n); spv[n] = *(const v4f*)(SP + ch0 + 16 * n); }
#pragma unroll
        for (int n = 0; n < 2; ++n) { const int ch = ch0 + 16 * n; const v4f bi = biv[n], br = brv[n], sp = spv[n];
#pragma unroll
            for (int ai = 0; ai < 2; ++ai)
#pragma unroll
                for (int m = 0; m < 4; ++m) { const int row = row0 + ai * 128 + m * 16; const bool first = (row & (SEQ - 1)) == 0; const size_t off = (size_t)row * DM + ch;
                    const v2u xw = xv[n][ai][m]; const float x[4] = {bflo(xw.x), bfhi(xw.x), bflo(xw.y), bfhi(xw.y)};
                    const pg8::f32x4 vi = acc[ai][0][m][n], vr = acc[ai][1][m][n]; v4u av;
#pragma unroll
                    for (int j = 0; j < 4; ++j) { const float ig = sigmoidf_(vi[j] + bi[j]), rg = sigmoidf_(vr[j] + br[j]);
                        const float la = -8.0f * rg * sp[j];
                        const float oma = 1.0f - __expf(la);
                        const float mult = first ? 1.0f : __builtin_amdgcn_sqrtf(oma * (2.0f - oma));
                        av[j] = pg8::cvt_pk_bf16(oma, mult * ig * x[j]); }
                    *(v4u*)(AU + off) = av;
                    if (m & 1) asm volatile("" ::: "memory"); } }
    }
};

constexpr int HG_Q = 0, HG_K = 16384, HG_V = 32768, HG_KH = 49152  , HG_S = 67584  , HG_O = 100352  , HG_DEC = 117760, HG_CS = 118272  , HG_GN = 122368  ;

__device__ __forceinline__ void hg_qkt1(at::f32x16& p, const char* Ks, int rowbase, const at::bf16x8* qr, int r32, int hi) {
  p = at::f32x16{};
  at::bf16x8 kf[8];
#pragma unroll
  for (int d0 = 0; d0 < 8; ++d0) kf[d0] = *reinterpret_cast<const at::bf16x8*>(Ks + KSWZ(rowbase + r32, (d0 * 16 + hi * 8) * 2));
#pragma unroll
  for (int d0 = 0; d0 < 8; ++d0) p = __builtin_amdgcn_mfma_f32_32x32x16_bf16(kf[d0], qr[d0], p, 0, 0, 0);
}
__device__ __forceinline__ void hg_pv_half(at::f32x16& od, int vb, at::bf16x8 pa0, at::bf16x8 pa1) {
  using namespace at;
  const s16x4 l0 = tr_read<v_rd_off(0, 0, 0)>(vb), h0 = tr_read<v_rd_off(0, 0, 1)>(vb), l1 = tr_read<v_rd_off(0, 1, 0)>(vb), h1 = tr_read<v_rd_off(0, 1, 1)>(vb);
  asm volatile("s_waitcnt lgkmcnt(0)" ::: "memory"); SBAR();
#define PK(L, H) (bf16x8){L[0], L[1], L[2], L[3], H[0], H[1], H[2], H[3]}
  od = __builtin_amdgcn_mfma_f32_32x32x16_bf16(pa0, PK(l0, h0), od, 0, 0, 0);
  od = __builtin_amdgcn_mfma_f32_32x32x16_bf16(pa1, PK(l1, h1), od, 0, 0, 0);
#undef PK
}

__device__ __forceinline__ void hg_mfma(Frame& F, bf16* Y, int u, unsigned* prog = nullptr) {
  using namespace at;
  const bf16* proj = (const bf16*)FW(F, WS_PROJ);
  const float* LB = (const float*)FW(F, WS_MISC + MISC_LB);
  unsigned char* lds = F.lds;
  const int wid = F.wave;
  {
    int lane = F.lane; asm volatile("" : "+v"(lane));
    const int tid = wid * 64 + lane, r32 = lane & 31, hi = lane >> 5;
    const int b = u >> 5, hd = u & 31;
    const int dp = lane, te = wid;
    const int sr = tid >> 4, sc = (tid & 15) * 8;
    const int tb = wid & 1, vb = wid >> 1;
    const int dblk = wid >> 1, vblk0 = 2 * (wid & 1);
    const int vbV = (int)(uintptr_t)((LAS unsigned char*)lds + HG_V) + v_rd_base(lane);
    const int vbS = (int)(uintptr_t)((LAS unsigned char*)lds + HG_S) + v_rd_base(lane);
    const float lb0 = LB[hd * 128 + 2 * dp], lb1 = LB[hd * 128 + 2 * dp + 1];
    const size_t row0 = (size_t)b * SEQ;
    f32x16 Sa = f32x16{}, Sb = f32x16{};
    v4u ga, gb;
    __syncthreads();
    for (int i = tid; i < 32768 / 16; i += NTHREADS) { v4u z; z.x = 0u; z.y = 0u; z.z = 0u; z.w = 0u; *(v4u*)(lds + HG_S + i * 16) = z; }
    if (tid < 128) ((float*)(lds + HG_GN))[tid] = FIN(F, 17)[tid];
    unsigned qraw[8], fraw[8]; v4u vs0, vs1;
#define HG_LOAD(c) do { const size_t rr_ = row0 + (size_t)(c) * 64; \
      _Pragma("unroll") for (int i = 0; i < 8; ++i) { const size_t o_ = (rr_ + 8 * te + i) * HG_NP + hd * 128 + 2 * dp; qraw[i] = *(const unsigned*)(proj + o_); fraw[i] = *(const unsigned*)(proj + o_ + 4096); } \
      vs0 = *(const v4u*)(proj + (rr_ + sr) * HG_NP + 8192 + hd * 128 + sc); vs1 = *(const v4u*)(proj + (rr_ + 32 + sr) * HG_NP + 8192 + hd * 128 + sc); } while (0)
    HG_LOAD(0);
    for (int c = 0; c < SEQ / 64; ++c) {
      float q0[8], q1[8], k0[8], k1[8], c0[8], c1[8];
      { float a0 = 0.f, a1 = 0.f;
#pragma unroll
        for (int i = 0; i < 8; ++i) { const float f0 = lb0 + (1.f - lb0) * sigmoidf_(bflo(fraw[i])), f1 = lb1 + (1.f - lb1) * sigmoidf_(bfhi(fraw[i]));
          q0[i] = siluf_(bflo(qraw[i])); q1[i] = siluf_(bfhi(qraw[i])); k0[i] = 1.f - f0; k1[i] = 1.f - f1;
          a0 += __logf(f0); a1 += __logf(f1); c0[i] = a0; c1[i] = a1; } }
      { float* cs = (float*)(lds + HG_CS); cs[te * 128 + 2 * dp] = c0[7]; cs[te * 128 + 2 * dp + 1] = c1[7]; }
      *(v4u*)(lds + HG_V + v_st(sr, sc)) = vs0; *(v4u*)(lds + HG_V + v_st(32 + sr, sc)) = vs1;
      __syncthreads();
      { const float* cs = (const float*)(lds + HG_CS); float off0 = 0.f, off1 = 0.f, tot0 = 0.f, tot1 = 0.f;
#pragma unroll
        for (int s = 0; s < 8; ++s) { const v2f x = *(const v2f*)(cs + s * 128 + 2 * dp); tot0 += x.x; tot1 += x.y; if (s < te) { off0 += x.x; off1 += x.y; } }
        unsigned kh0[4], kh1[4]; const float et0 = __expf(tot0), et1 = __expf(tot1);
#pragma unroll
        for (int i = 0; i < 8; ++i) { const float b0 = off0 + c0[i], b1 = off1 + c1[i]; const int t = 8 * te + i;
          const float e0 = __expf(b0), e1 = __expf(b1), r0 = __builtin_amdgcn_rcpf(e0), r1 = __builtin_amdgcn_rcpf(e1);
          *(unsigned*)(lds + HG_Q + KSWZ(t, 4 * dp)) = at::cvtpk(q0[i] * e0, q1[i] * e1);
          const float kt0 = k0[i] * r0, kt1 = k1[i] * r1;
          *(unsigned*)(lds + HG_K + KSWZ(t, 4 * dp)) = at::cvtpk(kt0, kt1);
          const float h0 = kt0 * et0, h1 = kt1 * et1;
          if (i & 1) { kh0[i >> 1] |= f2bf(h0) << 16; kh1[i >> 1] |= f2bf(h1) << 16; } else { kh0[i >> 1] = f2bf(h0); kh1[i >> 1] = f2bf(h1); } }
        { v4u w; w.x = kh0[0]; w.y = kh0[1]; w.z = kh0[2]; w.w = kh0[3]; *(v4u*)(lds + HG_KH + (2 * dp) * 144 + te * 16) = w;
          w.x = kh1[0]; w.y = kh1[1]; w.z = kh1[2]; w.w = kh1[3]; *(v4u*)(lds + HG_KH + (2 * dp + 1) * 144 + te * 16) = w; }
        if (te == 0) { float* dec = (float*)(lds + HG_DEC); dec[2 * dp] = et0; dec[2 * dp + 1] = et1; } }
      if (c + 1 < SEQ / 64) HG_LOAD(c + 1);
      __syncthreads();
      { const size_t row_ = row0 + (size_t)c * 64 + (tid >> 3); ga = *(const v4u*)(proj + row_ * HG_NP + 12288 + hd * 128 + (tid & 7) * 16); gb = *(const v4u*)(proj + row_ * HG_NP + 12288 + hd * 128 + (tid & 7) * 16 + 8); }
      {
        bf16x8 qr[8];
#pragma unroll
        for (int d0 = 0; d0 < 8; ++d0) qr[d0] = *reinterpret_cast<const bf16x8*>((const char*)lds + HG_Q + KSWZ(32 * tb + r32, (d0 * 16 + hi * 8) * 2));
        f32x16 o = f32x16{};
        {
          f32x16 pd; hg_qkt1(pd, (const char*)lds + HG_K, 32 * tb, qr, r32, hi);
#pragma unroll
          for (int r = 0; r < 16; ++r) { const int cr = (r & 3) + 8 * (r >> 2) + 4 * hi; pd[r] = (cr > r32) ? 0.f : pd[r]; }
          bf16x8 pa0, pa1, pa2, pa3;
          if (tb == 0) { PK4(pd, 0, pa0); PK4(pd, 8, pa1); hg_pv_half(o, vbV + vb * 512, pa0, pa1); }
          else { f32x16 pf; hg_qkt1(pf, (const char*)lds + HG_K, 0, qr, r32, hi);
#pragma unroll
            for (int r = 0; r < 16; ++r) pf[r] = __builtin_fmaxf(pf[r], -3.0e38f);
            PK4(pf, 0, pa0); PK4(pf, 8, pa1); PK4(pd, 0, pa2); PK4(pd, 8, pa3); pv_one<0>(o, vbV + vb * 512, pa0, pa1, pa2, pa3); }
        }
        pv_one<0>(o, vbS + vb * 512, qr[0], qr[1], qr[2], qr[3]);
        pv_one<0>(o, vbS + 16384 + vb * 512, qr[4], qr[5], qr[6], qr[7]);
#pragma unroll
        for (int r = 0; r < 16; ++r) { const int t = 32 * tb + crow(r, hi); *(bf16*)(lds + HG_O + t * 272 + (32 * vb + r32) * 2) = (bf16)f2bf(o[r]); }
        { const float* dec = (const float*)(lds + HG_DEC);
#pragma unroll
          for (int r = 0; r < 16; ++r) { const float dv = dec[32 * dblk + crow(r, hi)]; Sa[r] *= dv; Sb[r] *= dv; }
          bf16x8 kh[4];
#pragma unroll
          for (int ks = 0; ks < 4; ++ks) kh[ks] = *reinterpret_cast<const bf16x8*>((const char*)lds + HG_KH + (32 * dblk + r32) * 144 + (16 * ks + 8 * hi) * 2);
          pv_one<0>(Sa, vbV + vblk0 * 512, kh[0], kh[1], kh[2], kh[3]);
          pv_one<0>(Sb, vbV + (vblk0 + 1) * 512, kh[0], kh[1], kh[2], kh[3]); }
      }
      const bool post = prog && (c & 3) == 0 && c > 0 && c <= 16;
      if (post) asm volatile("s_waitcnt vmcnt(0)" ::: "memory");
      __syncthreads();
      if (post && tid == 0) { __builtin_amdgcn_fence(__ATOMIC_RELEASE, "agent"); asm volatile("s_waitcnt vmcnt(0)" ::: "memory"); (void)xb_add(prog + b * 8 + (c >> 2) - 1, 1u); }
#pragma unroll
      for (int r = 0; r < 16; ++r) { const int d = 32 * dblk + crow(r, hi);
        *(bf16*)(lds + HG_S + (d >> 6) * 16384 + v_st(d & 63, 32 * vblk0 + r32)) = (bf16)f2bf(Sa[r]);
        *(bf16*)(lds + HG_S + (d >> 6) * 16384 + v_st(d & 63, 32 * (vblk0 + 1) + r32)) = (bf16)f2bf(Sb[r]); }
      { const int t = tid >> 3, seg = tid & 7; const size_t row = row0 + (size_t)c * 64 + t;
        const v4u oa = *(const v4u*)(lds + HG_O + t * 272 + seg * 32), ob = *(const v4u*)(lds + HG_O + t * 272 + seg * 32 + 16);
        const unsigned ow[8] = {oa.x, oa.y, oa.z, oa.w, ob.x, ob.y, ob.z, ob.w}, gw[8] = {ga.x, ga.y, ga.z, ga.w, gb.x, gb.y, gb.z, gb.w};
        float ss = 0.f;
#pragma unroll
        for (int i = 0; i < 8; ++i) { const float a = bflo(ow[i]), bq = bfhi(ow[i]); ss += a * a + bq * bq; }
        ss += __shfl_xor(ss, 1); ss += __shfl_xor(ss, 2); ss += __shfl_xor(ss, 4);
        const float rstd = rsqrtf(ss * (1.f / 128.f) + NORM_EPS);
        unsigned yw[8]; const float* gnl = (const float*)(lds + HG_GN) + seg * 16;
#pragma unroll
        for (int i = 0; i < 8; ++i) { const v2f g2 = *(const v2f*)(gnl + 2 * i); const float gx = g2.x, gy = g2.y;
          yw[i] = at::cvtpk(bflo(ow[i]) * rstd * gx * siluf_(bflo(gw[i])), bfhi(ow[i]) * rstd * gy * siluf_(bfhi(gw[i]))); }
        v4u y0, y1; y0.x = yw[0]; y0.y = yw[1]; y0.z = yw[2]; y0.w = yw[3]; y1.x = yw[4]; y1.y = yw[5]; y1.z = yw[6]; y1.w = yw[7];
        *(v4u*)(Y + row * DM + hd * 128 + seg * 16) = y0; *(v4u*)(Y + row * DM + hd * 128 + seg * 16 + 8) = y1; }
    }
#undef HG_LOAD
  }
  __syncthreads();
}

constexpr size_t MISC_W1T = 4 * MiB;
constexpr size_t MISC_W2T = 8 * MiB;
__device__ __forceinline__ unsigned pk2n(float lo, float hi) { unsigned r; asm("v_cvt_pk_bf16_f32 %0, %1, %2" : "=v"(r) : "v"(lo), "v"(hi)); return r; }
__device__ __forceinline__ void nsa_compress_mfma(Frame& F, int j) {
    typedef short bf16x8 __attribute__((ext_vector_type(8)));
    typedef float f32x4 __attribute__((ext_vector_type(4)));
    const bf16* proj = (const bf16*)FW(F, WS_PROJ);
    float* red = (float*)(F.lds);
    bf16* hid = (bf16*)(F.lds + 65536);
    const int wid = F.wave;
    for (int u = F.vcu; u < 256; u += F.G) {
        int lane = F.lane; asm volatile("" : "+v"(lane));
        const int tid = wid * 64 + lane, r16 = lane & 15, kq = lane >> 4;
        const int which = u >> 7, T = u & 127, b = T >> 5, n0 = 4 * (T & 31);
        const int n = n0 + (r16 >> 2), g = r16 & 3; const bool valid = n < 127;
        const bf16* W1T = (const bf16*)FW(F, WS_MISC + MISC_W1T) + (size_t)(j * 2 + which) * 128 * 4096;
        const bf16* W2T = (const bf16*)FW(F, WS_MISC + MISC_W2T) + (size_t)(j * 2 + which) * 128 * 128;
        const float* pe = FIN(F, 4) + (size_t)(j * 2 + which) * 32 * 128;
        const int col0 = which ? NSA_VC : NSA_KC;
        bf16* dst = (bf16*)FW(F, WS_SCR) + (size_t)which * (BATCH * 4 * 128 * 128);
        f32x4 acc[8];
#pragma unroll
        for (int ct = 0; ct < 8; ++ct) acc[ct] = (f32x4){0.f, 0.f, 0.f, 0.f};
        __syncthreads();
        const bf16* xrow = proj + (size_t)(b * SEQ + 16 * (valid ? n : 126)) * NSA_NP + col0 + g * 128 + 8 * kq;
        const bf16* wrow = W1T + (size_t)r16 * 4096 + 8 * kq; const float* perow = pe + 8 * kq;
        v4u xb[3]; v4f pb[3][2]; bf16x8 wb[3][8];
#define CMP_LOAD(S_, SL_) do { const int l_ = 4 * wid + ((S_) >> 2), d_ = 32 * ((S_) & 3); \
            xb[SL_] = *(const v4u*)(xrow + (size_t)l_ * NSA_NP + d_); pb[SL_][0] = *(const v4f*)(perow + l_ * 128 + d_); pb[SL_][1] = *(const v4f*)(perow + l_ * 128 + d_ + 4); \
            _Pragma("unroll") for (int ct = 0; ct < 8; ++ct) wb[SL_][ct] = *(const bf16x8*)(wrow + (size_t)(ct * 16) * 4096 + l_ * 128 + d_); } while (0)
        CMP_LOAD(0, 0); CMP_LOAD(1, 1);
#pragma unroll
        for (int s = 0; s < 16; ++s) {
            if (s + 2 < 16) CMP_LOAD(s + 2, (s + 2) % 3);
            __builtin_amdgcn_sched_barrier(0);
            const v4u x = xb[s % 3]; const v4f p0 = pb[s % 3][0], p1 = pb[s % 3][1];
            v4u aw; aw.x = pk2n(bflo(x.x) + p0.x, bfhi(x.x) + p0.y); aw.y = pk2n(bflo(x.y) + p0.z, bfhi(x.y) + p0.w);
            aw.z = pk2n(bflo(x.z) + p1.x, bfhi(x.z) + p1.y); aw.w = pk2n(bflo(x.w) + p1.z, bfhi(x.w) + p1.w);
            aw.x = valid ? aw.x : 0u; aw.y = valid ? aw.y : 0u; aw.z = valid ? aw.z : 0u; aw.w = valid ? aw.w : 0u;
            const bf16x8 af = __builtin_bit_cast(bf16x8, aw);
#pragma unroll
            for (int ct = 0; ct < 8; ++ct) acc[ct] = __builtin_amdgcn_mfma_f32_16x16x32_bf16(af, wb[s % 3][ct], acc[ct], 0, 0, 0);
            __builtin_amdgcn_sched_barrier(0);
        }
#undef CMP_LOAD
#pragma unroll
        for (int ct = 0; ct < 8; ++ct)
#pragma unroll
            for (int q = 0; q < 4; ++q) red[(wid * 16 + kq * 4 + q) * 128 + ct * 16 + r16] = acc[ct][q];
        __syncthreads();
        { const int idx = tid * 4, row = idx >> 7, col = idx & 127; v4f sacc = *(const v4f*)(red + row * 128 + col);
#pragma unroll
          for (int w = 1; w < 8; ++w) { const v4f x = *(const v4f*)(red + (w * 16 + row) * 128 + col); sacc.x += x.x; sacc.y += x.y; sacc.z += x.z; sacc.w += x.w; }
          v2u o; o.x = pk2(gelu_tanh(sacc.x), gelu_tanh(sacc.y)); o.y = pk2(gelu_tanh(sacc.z), gelu_tanh(sacc.w));
          *(v2u*)(hid + row * 136 + col) = o; }
        __syncthreads();
        { f32x4 a2 = (f32x4){0.f, 0.f, 0.f, 0.f};
#pragma unroll
          for (int s = 0; s < 4; ++s) { const bf16x8 af = *(const bf16x8*)(hid + r16 * 136 + 32 * s + 8 * kq);
              const bf16x8 bfr = *(const bf16x8*)(W2T + (size_t)(wid * 16 + r16) * 128 + 32 * s + 8 * kq);
              a2 = __builtin_amdgcn_mfma_f32_16x16x32_bf16(af, bfr, a2, 0, 0, 0); }
#pragma unroll
          for (int q = 0; q < 4; ++q) { const int row = kq * 4 + q, nn = n0 + (row >> 2), gg = row & 3;
              dst[((size_t)(b * 4 + gg) * 128 + nn) * 128 + wid * 16 + r16] = (nn < 127) ? (bf16)f2bf(a2[q]) : (bf16)0; } }
    }
    __syncthreads();
}

#ifndef MK_ONE_LAUNCH
#define MK_ONE_LAUNCH 1
#endif
constexpr int NPHASE = 21;
static_assert((CW_BAR + XCD_BAR_WORDS) * 4 <= (int)CTL_ZERO_BYTES, "the per-call memset covers the grid-barrier words");
struct Args { const float* in[19]; float* out; unsigned char* ws; int ph_lo, ph_hi, li, pad; };

#define GEMM_BF16(Aptr, Bptr, N_, Optr, ldc_) do { \
        pg8::Gemm g_{(const pg8::bf16_t*)(Aptr), (const pg8::bf16_t*)(Bptr), MTOK, (N_), DM, DM, 0}; pg8::StaticOrder S_; S_.init(MTOK, (N_), F.G, (int)blockIdx.x); \
        pg8::EpiBf16<0> E_{(pg8::bf16_t*)(Optr), (ldc_), nullptr, 0, 0, 1.f}; \
        pg8::gemm_phase<pg8::EpiBf16<0>, pg8::StaticOrder, true, true>((PG8_LAS unsigned char*)lds + RING_OFF, g_, S_, E_); } while (0)

#define GEMM_IN(Bptr, N_) do { \
        pg8::Gemm g_{(const pg8::bf16_t*)FW(F, WS_H), (const pg8::bf16_t*)(Bptr), MTOK, (N_), DM, DM, 0}; pg8::StaticOrder S_; S_.init(MTOK, (N_), F.G, (int)blockIdx.x); \
        pg8::EpiBf16RS E_{(pg8::bf16_t*)FW(F, WS_PROJ), (N_), (const float*)FW(F, WS_MISC + MISC_RS)}; \
        pg8::gemm_phase<pg8::EpiBf16RS, pg8::StaticOrder, true, true>((PG8_LAS unsigned char*)lds + RING_OFF, g_, S_, E_); } while (0)

constexpr int CW_HGF = 128, CW_WOF = 192;
struct SchedEarly {
    int j; unsigned* hgf; unsigned* wof; unsigned* bar;
    __device__ __forceinline__ bool next(int i, pg8::Unit& u) const { if (i >= 2) return false; u.pm = 8 * (j >> 5) + 2 * i + ((j >> 4) & 1); u.pn = j & 15; return true; }
    __device__ __forceinline__ void a_ready(const pg8::Unit& u) const {
        XB_SPIN(xb_ld(wof) < 128u, bar); XB_SPIN(xb_ld(hgf + (u.pm >> 3) * 8 + (u.pm & 7)) < 32u, bar);
        __builtin_amdgcn_fence(__ATOMIC_ACQUIRE, "agent"); asm volatile("s_waitcnt vmcnt(0)" ::: "memory"); }
    __device__ __forceinline__ void done(const pg8::Unit&) const {}
};
struct SchedLate {
    int c;
    __device__ __forceinline__ bool next(int i, pg8::Unit& u) const { if (i >= 1) return false; const int x = c & 7, l = c >> 3; u.pm = 8 * (x >> 1) + 4 + (l & 3); u.pn = 8 * (x & 1) + (l >> 2); return true; }
    __device__ __forceinline__ void a_ready(const pg8::Unit&) const {}
    __device__ __forceinline__ void done(const pg8::Unit&) const {}
};
#define GEMM_WOUT_SCHED(SCHED, S_init) do { \
        pg8::Gemm g_{(const pg8::bf16_t*)FW(F, WS_Y), (const pg8::bf16_t*)FW(F, WS_W_HG_OUT), MTOK, DM, DM, DM, 0}; SCHED S_ S_init; \
        pg8::EpiBf16<0> E_{(pg8::bf16_t*)FW(F, WS_YO), DM, nullptr, 0, 0, 1.f}; \
        pg8::gemm_phase<pg8::EpiBf16<0>, SCHED, true, true>((PG8_LAS unsigned char*)lds + RING_OFF, g_, S_, E_); } while (0)

constexpr int CW_PF = 224;
struct SchedP {
    int e; unsigned* pf; unsigned* bar;
    __device__ __forceinline__ bool next(int i, pg8::Unit& u) const { if (i >= 2) return false; u.pm = e >> 2; u.pn = 4 * i + (e & 3); return true; }
    __device__ __forceinline__ void a_ready(const pg8::Unit& u) const { XB_SPIN(xb_ld(pf + (u.pn >> 2)) < 128u, bar); __builtin_amdgcn_fence(__ATOMIC_ACQUIRE, "agent"); asm volatile("s_waitcnt vmcnt(0)" ::: "memory"); }
    __device__ __forceinline__ void done(const pg8::Unit&) const {}
};
#define GEMM_IN2(Bptr, N_, Optr, ldc_) do { \
        pg8::Gemm g_{(const pg8::bf16_t*)FW(F, WS_H), (const pg8::bf16_t*)(Bptr), MTOK, (N_), DM, DM, 0}; pg8::StaticOrder S_; S_.init(MTOK, (N_), F.G, (int)blockIdx.x); \
        pg8::EpiBf16RS E_{(pg8::bf16_t*)(Optr), (ldc_), (const float*)FW(F, WS_MISC + MISC_RS)}; \
        pg8::gemm_phase<pg8::EpiBf16RS, pg8::StaticOrder, true, true>((PG8_LAS unsigned char*)lds + RING_OFF, g_, S_, E_); } while (0)

__device__ __forceinline__ bool phase_begin(Frame& F) { asm volatile("" : "+v"(F.tid)); asm volatile("" : "+s"(F.kin)); F.lane = F.tid & 63; return true; }

__global__ void __launch_bounds__(NTHREADS, 2) fwd_kernel(Args args) {
    extern __shared__ __attribute__((aligned(16))) unsigned char lds[];
    Frame F;
    F.lds = lds;
    F.tid = threadIdx.x; F.lane = F.tid & 63; F.wave = __builtin_amdgcn_readfirstlane(F.tid >> 6);
    F.G = gridDim.x; { const int bx = blockIdx.x; F.vcu = (F.G % 8 == 0) ? (bx % 8) * (F.G / 8) + bx / 8 : bx; }
    F.gw = F.vcu * NWAVES + F.wave; F.ngw = F.G * NWAVES;
    F.kin = (const float* const __attribute__((address_space(4)))*)__builtin_amdgcn_kernarg_segment_ptr();
    F.out = args.out; F.ws = args.ws;
    volatile LAS unsigned* MISC = (volatile LAS unsigned*)((LAS unsigned char*)lds + MISC_OFF);
    if (F.tid < 32) MISC[F.tid] = 0u;
    __syncthreads();
    const int lo = args.ph_lo, hi = args.ph_hi;
    unsigned* barw = (unsigned*)(F.ws + WS_CTL) + CW_BAR + args.li * XCD_BAR_WORDS;
    XcdBarrier bar; bar.bar = barw; bar.x = 0; bar.st = nullptr;
    if (hi - lo > 1) bar = xcd_barrier_post(barw, MISC + 8);
#define IN(k) (lo <= (k) && (k) < hi && phase_begin(F))
#define SEAM(k) do { if (lo <= (k) && (k) + 1 < hi) xcd_barrier(bar); } while (0)

    const bool p_split = (F.G == 256) && (lo <= 0 && 1 < hi);
    if (IN(0)) { p0_prologue(F, p_split); } SEAM(0);

    if (IN(1)) {
        if (p_split) { const int li = F.vcu & 31, xg = F.vcu >> 5; unsigned* ctl = (unsigned*)(F.ws + WS_CTL);
            if (li >= 16) p0_split_convert(F, xg * 16 + li - 16, 128, ctl + CW_PF);
            else { pg8::Gemm g_{(const pg8::bf16_t*)FW(F, WS_H), (const pg8::bf16_t*)FW(F, WS_W_NSA_IN), MTOK, NSA_NP, DM, DM, 0}; SchedP S_{xg * 16 + li, ctl + CW_PF, barw};
                pg8::EpiBf16RS E_{(pg8::bf16_t*)FW(F, WS_PROJ), NSA_NP, (const float*)FW(F, WS_MISC + MISC_RS)};
                pg8::gemm_phase<pg8::EpiBf16RS, SchedP, true, true>((PG8_LAS unsigned char*)lds + RING_OFF, g_, S_, E_);
                __syncthreads(); p0_split_tail(F, xg * 16 + li, 128); }
            xcd_barrier(bar);
            phase_begin(F);
            GEMM_IN2(FW(F, WS_W_NSA_IN + (size_t)2048 * DM * 2), NSA_NP - 2048, FW(F, WS_PROJ + (size_t)2048 * 2), NSA_NP); }
        else GEMM_IN(FW(F, WS_W_NSA_IN), NSA_NP);
        if (F.G == 256 && blockIdx.x >= 160) { __syncthreads(); p0_rg_in(F, (int)blockIdx.x - 160, 96); } } SEAM(1);
    if (IN(2)) { nsa_compress_mfma(F, 0); } SEAM(2);
    if (IN(3)) { nsa_attn_mfma<0>(F, (bf16*)FW(F, WS_Y)); } SEAM(3);
    if (IN(4)) { GEMM_BF16(FW(F, WS_Y), FW(F, WS_W_NSA_OUT), DM, FW(F, WS_YO), DM); } SEAM(4);
    if (IN(5)) { resid_phase(F, nullptr, (const bf16*)FW(F, WS_YO), FIN(F, 2) + 0 * DM, (bf16*)FW(F, WS_H), (float*)FW(F, WS_MISC + MISC_RS), nullptr); } SEAM(5);

    if (IN(6)) { GEMM_IN(FW(F, WS_W_RG_IN), RG_NP); } SEAM(6);
    if (IN(7)) { rg_conv(F); } SEAM(7);
    if (IN(8)) { int kk_ = 256; asm volatile("" : "+s"(kk_));
        pg8::Gemm g_{(const pg8::bf16_t*)FW(F, WS_Y), (const pg8::bf16_t*)FW(F, WS_MISC + MISC_GATE), MTOK, 8192, kk_, DM, 1}; pg8::StaticOrder S_; S_.init(MTOK, 8192, F.G, (int)blockIdx.x);
        EpiRG E_{(const bf16*)FW(F, WS_Y), FIN(F, 12), (const float*)FW(F, WS_MISC + MISC_SP), (unsigned*)FW(F, WS_SCR)};
        pg8::gemm_phase<EpiRG, pg8::StaticOrder, true, true>((PG8_LAS unsigned char*)lds + RING_OFF, g_, S_, E_); } SEAM(8);
    if (IN(9)) { rg_scan(F); } SEAM(9);
    if (IN(10)) { GEMM_BF16(FW(F, WS_Y), FW(F, WS_W_RG_OUT), DM, FW(F, WS_YO), DM); } SEAM(10);
    if (IN(11)) { resid_phase(F, nullptr, (const bf16*)FW(F, WS_YO), FIN(F, 2) + 1 * DM, (bf16*)FW(F, WS_H), (float*)FW(F, WS_MISC + MISC_RS), nullptr); } SEAM(11);

    if (IN(12)) { GEMM_IN(FW(F, WS_W_HG_IN), HG_NP); } SEAM(12);
    const bool hg_early = (F.G == 256) && (lo <= 13 && 14 < hi);
    if (IN(13)) {
        if (F.G == 256) { const int li = F.vcu & 31, xg = F.vcu >> 5; unsigned* ctl = (unsigned*)(F.ws + WS_CTL);
            if (li < 16) hg_mfma(F, (bf16*)FW(F, WS_Y), xg * 16 + li, hg_early ? ctl + CW_HGF : nullptr);
            else if (!hg_early) p0_deferred(F, xg * 16 + li - 16, 128);
            else { const int j = xg * 16 + li - 16;
                p0_deferred(F, j, 128, 0);
                asm volatile("s_waitcnt vmcnt(0)" ::: "memory"); __syncthreads();
                if (F.tid == 0) { __builtin_amdgcn_fence(__ATOMIC_RELEASE, "agent"); asm volatile("s_waitcnt vmcnt(0)" ::: "memory"); (void)xb_add(ctl + CW_WOF, 1u); }
                p0_deferred(F, j, 128, 1);
                __syncthreads();
                GEMM_WOUT_SCHED(SchedEarly, ({j, ctl + CW_HGF, ctl + CW_WOF, barw})); } }
        else { for (int u = F.vcu; u < BATCH * 32; u += F.G) hg_mfma(F, (bf16*)FW(F, WS_Y), u); p0_deferred(F, F.vcu, F.G); } } SEAM(13);
    if (IN(14)) { if (hg_early) GEMM_WOUT_SCHED(SchedLate, ({(int)blockIdx.x})); else GEMM_BF16(FW(F, WS_Y), FW(F, WS_W_HG_OUT), DM, FW(F, WS_YO), DM); } SEAM(14);
    if (IN(15)) { resid_phase(F, nullptr, (const bf16*)FW(F, WS_YO), FIN(F, 2) + 2 * DM, (bf16*)FW(F, WS_H), (float*)FW(F, WS_MISC + MISC_RS), nullptr); } SEAM(15);

    if (IN(16)) { GEMM_IN(FW(F, WS_W_NSA_IN + (size_t)NSA_NP * DM * 2), NSA_NP);
        if (hg_early && blockIdx.x >= 160) { __syncthreads(); p0_deferred(F, (int)blockIdx.x - 160, 96, 2); } } SEAM(16);
    if (IN(17)) { nsa_compress_mfma(F, 1); } SEAM(17);
    if (IN(18)) { nsa_attn_mfma<0>(F, (bf16*)FW(F, WS_Y)); } SEAM(18);
    if (IN(19)) { GEMM_BF16(FW(F, WS_Y), FW(F, WS_W_NSA_OUT + (size_t)DM * DM * 2), DM, FW(F, WS_YO), DM); } SEAM(19);
    if (IN(20)) { resid_phase(F, nullptr, (const bf16*)FW(F, WS_YO), FIN(F, 2) + 3 * DM, (bf16*)FW(F, WS_H), nullptr, F.out); }
#undef IN
#undef SEAM
}

extern "C" void kernel_launch(void* const* d_in, const int* in_sizes, int n_in, void* d_out, int out_size, void* d_ws, size_t ws_size, hipStream_t stream) {
    static int grid = 0;
    if (grid == 0) {
        if (n_in != 19 || out_size != MTOK * DM || ws_size < WS_END) { fprintf(stderr, "kernel_launch: unexpected shapes (n_in %d out %d ws %zu)\n", n_in, out_size, ws_size); grid = -1; return; }
        int dev = 0, cus = 0, per_cu = 0;
        if (hipGetDevice(&dev) != hipSuccess || hipDeviceGetAttribute(&cus, hipDeviceAttributeMultiprocessorCount, dev) != hipSuccess) { grid = -1; return; }
        if (hipFuncSetAttribute((const void*)fwd_kernel, hipFuncAttributeMaxDynamicSharedMemorySize, LDS_BYTES) != hipSuccess) { fprintf(stderr, "kernel_launch: hipFuncSetAttribute failed\n"); grid = -1; return; }
        if (hipOccupancyMaxActiveBlocksPerMultiprocessor(&per_cu, (const void*)fwd_kernel, NTHREADS, LDS_BYTES) != hipSuccess || per_cu < 1) { fprintf(stderr, "kernel_launch: occupancy query says %d\n", per_cu); }
        (void)hipGetLastError();
        grid = cus;
    }
    if (grid < 0) return;
    (void)hipMemsetAsync((char*)d_ws + WS_CTL, 0, CTL_ZERO_BYTES, stream);
    Args a{};
    for (int i = 0; i < 19; ++i) a.in[i] = (const float*)d_in[i];
    a.out = (float*)d_out; a.ws = (unsigned char*)d_ws; a.pad = 0;
#if MK_ONE_LAUNCH
    a.ph_lo = 0; a.ph_hi = NPHASE; a.li = 0;
    hipLaunchKernelGGL(fwd_kernel, dim3(grid), dim3(NTHREADS), LDS_BYTES, stream, a);
#else
    for (int p = 0; p < NPHASE; ++p) { a.ph_lo = p; a.ph_hi = p + 1; a.li = 0; hipLaunchKernelGGL(fwd_kernel, dim3(grid), dim3(NTHREADS), LDS_BYTES, stream, a); }
#endif
}
```
